# Optimizing an MI355X kernel written in HIP

```python
import math
import jax, jax.numpy as jnp
from jax import lax
import numpy as np

D_MODEL = 1024
BATCH = 4
SEQ = 8192
DEPTH = 4

GRID_W = 64
CTX_LEN = 256
RMS_EPS = 1e-6
ROPE_THETA = 10000.0
Q_BLOCK = 128

MLA_HEADS = 8
MLA_NOPE = 64
MLA_ROPE = 32
MLA_V = 64
MLA_Q_RANK = 256
MLA_KV_RANK = 128
MLA_WIDTH = MLA_HEADS * MLA_V
MLA_SCALE = (MLA_NOPE + MLA_ROPE) ** -0.5

LRU_WIDTH = 512
LRU_BLOCKS = 8
LRU_BLOCK = LRU_WIDTH // LRU_BLOCKS
LRU_CONV = 4
LRU_C = 8.0

NA_HEADS = 16
NA_HEAD_DIM = 64
NA_WIDTH = NA_HEADS * NA_HEAD_DIM
NA_WIN_R = 8
NA_WIN_C = 16

N_EVEN = (DEPTH + 1) // 2
N_ODD = DEPTH // 2
EVEN_SIZES = (MLA_Q_RANK, MLA_KV_RANK, MLA_ROPE, MLA_WIDTH, LRU_WIDTH, LRU_WIDTH)
EVEN_IN = sum(EVEN_SIZES)
EVEN_SPLITS = tuple(int(v) for v in np.cumsum(EVEN_SIZES)[:-1])
EVEN_MIX = MLA_WIDTH + LRU_WIDTH
ODD_IN = 4 * NA_WIDTH

kernel_name = 'hybrid_mla_rglru_natten_prefix_dit'


def _rmsnorm(x, g):
    xf = x.astype(jnp.float32)
    y = xf * lax.rsqrt(jnp.mean(xf * xf, axis=-1, keepdims=True) + RMS_EPS)
    return (y * g.astype(jnp.float32)).astype(x.dtype)


def _adaln(cond, w, b):
    m = jax.nn.silu(cond) @ w + b
    return jnp.split(m, 3, axis=-1)


def _rope_2d_tables(n_tok):
    n_freq = MLA_ROPE // 4
    inv = ROPE_THETA ** (-jnp.arange(n_freq, dtype=jnp.float32) / n_freq)
    t = jnp.arange(n_tok, dtype=jnp.int32)
    ang_r = (t // GRID_W).astype(jnp.float32)[:, None] * inv
    ang_c = (t % GRID_W).astype(jnp.float32)[:, None] * inv
    return (jnp.cos(ang_r), jnp.sin(ang_r), jnp.cos(ang_c), jnp.sin(ang_c))


def _rotate(x, cos, sin):
    x1, x2 = jnp.split(x, 2, axis=-1)
    return jnp.concatenate([x1 * cos - x2 * sin, x2 * cos + x1 * sin], axis=-1)


def _rope_2d(x, tabs):
    cr, sr, cc, sc = tabs
    xr, xc = jnp.split(x.astype(jnp.float32), 2, axis=-1)
    return jnp.concatenate([_rotate(xr, cr, sr), _rotate(xc, cc, sc)], axis=-1).astype(x.dtype)


def _mla_attend(qn, qr, kn, kr, v):
    s = jnp.einsum('bhqd,bhkd->bhqk', qn, kn) + jnp.einsum('bhqd,bkd->bhqk', qr, kr)
    p = jax.nn.softmax(s.astype(jnp.float32) * MLA_SCALE, axis=-1)
    return jnp.einsum('bhqk,bhkd->bhqd', p.astype(v.dtype), v)


def _short_conv(x, w, b):
    k = w.shape[0]
    y = lax.conv_general_dilated(x, w[:, None, :], window_strides=(1,),
                                 padding=[(k // 2, k - 1 - k // 2)],
                                 dimension_numbers=('NWC', 'WIO', 'NWC'),
                                 feature_group_count=x.shape[-1])
    return y + b


def _rglru_coeffs(x, wa, ba, wx, bx, lam):
    b_, t_, w_ = x.shape
    xb = x.reshape(b_, t_, LRU_BLOCKS, LRU_BLOCK)
    r = jax.nn.sigmoid(jnp.einsum('btnk,nkj->btnj', xb, wa).reshape(b_, t_, w_) + ba)
    i = jax.nn.sigmoid(jnp.einsum('btnk,nkj->btnj', xb, wx).reshape(b_, t_, w_) + bx)
    log_a = -LRU_C * r.astype(jnp.float32) * jax.nn.softplus(-lam.astype(jnp.float32))
    a = jnp.exp(log_a)
    u = jnp.sqrt(-jnp.expm1(2.0 * log_a)) * (i * x).astype(jnp.float32)
    return a, u


def _linear_scan(a, u, h0):
    u = u.at[:, 0].add(a[:, 0] * h0)
    def comb(left, right):
        al, ul = left
        ar, ur = right
        return al * ar, ar * ul + ur
    _, h = lax.associative_scan(comb, (a, u), axis=1)
    return h


def _bidir_rglru(x_c, x_l, wa, ba, wx, bx, lam):
    outs_c, outs_l = [], []
    for d in range(2):
        a_c, u_c = _rglru_coeffs(x_c, wa[d], ba[d], wx[d], bx[d], lam[d])
        a_l, u_l = _rglru_coeffs(x_l, wa[d], ba[d], wx[d], bx[d], lam[d])
        if d == 1:
            a_c, u_c, a_l, u_l = (jnp.flip(t, 1) for t in (a_c, u_c, a_l, u_l))
        h_c = _linear_scan(a_c, u_c, jnp.zeros((x_c.shape[0], x_c.shape[2]), jnp.float32))
        h_l = _linear_scan(a_l, u_l, h_c[:, -1])
        if d == 1:
            h_c, h_l = jnp.flip(h_c, 1), jnp.flip(h_l, 1)
        outs_c.append(h_c)
        outs_l.append(h_l)
    return (outs_c[0] + outs_c[1]).astype(x_c.dtype), (outs_l[0] + outs_l[1]).astype(x_l.dtype)


def _even_mixer(h_c, h_l, w_in, q_norm, w_uq, kv_norm, w_ukv, conv_w, conv_b,
                wa, ba, wx, bx, lam, w_out, tabs, need_ctx):
    b_, c_, _ = h_c.shape
    s_ = h_l.shape[1]
    t_ = c_ + s_
    z = jnp.concatenate([h_c, h_l], axis=1) @ w_in
    cq, ckv, kr, g_mla, x_lru, g_lru = jnp.split(z, EVEN_SPLITS, axis=-1)
    q = (_rmsnorm(cq, q_norm) @ w_uq).reshape(b_, t_, MLA_HEADS, MLA_NOPE + MLA_ROPE).transpose(0, 2, 1, 3)
    kv = (_rmsnorm(ckv, kv_norm) @ w_ukv).reshape(b_, t_, MLA_HEADS, MLA_NOPE + MLA_V).transpose(0, 2, 1, 3)
    q_nope, q_rope = q[..., :MLA_NOPE], q[..., MLA_NOPE:]
    k_nope, v = kv[..., :MLA_NOPE], kv[..., MLA_NOPE:]
    q_rope_l = _rope_2d(q_rope[:, :, c_:], tabs)
    k_rope = jnp.concatenate([kr[:, :c_], _rope_2d(kr[:, c_:], tabs)], axis=1)
    nb = s_ // Q_BLOCK
    def to_blocks(t):
        return jnp.moveaxis(t.reshape(b_, MLA_HEADS, nb, Q_BLOCK, t.shape[-1]), 2, 0)
    o_l = lax.map(lambda qs: _mla_attend(qs[0], qs[1], k_nope, k_rope, v),
                  (to_blocks(q_nope[:, :, c_:]), to_blocks(q_rope_l)))
    o_l = jnp.moveaxis(o_l, 0, 2).reshape(b_, MLA_HEADS, s_, MLA_V).transpose(0, 2, 1, 3).reshape(b_, s_, MLA_WIDTH)
    u_c = _short_conv(x_lru[:, :c_], conv_w, conv_b)
    u_l = _short_conv(x_lru[:, c_:], conv_w, conv_b)
    r_c, r_l = _bidir_rglru(u_c, u_l, wa, ba, wx, bx, lam)
    y_l = jnp.concatenate([o_l * jax.nn.silu(g_mla[:, c_:]), r_l * jax.nn.silu(g_lru[:, c_:])], axis=-1) @ w_out
    y_c = None
    if need_ctx:
        o_c = _mla_attend(q_nope[:, :, :c_], q_rope[:, :, :c_], k_nope[:, :, :c_], k_rope[:, :c_], v[:, :, :c_])
        o_c = o_c.transpose(0, 2, 1, 3).reshape(b_, c_, MLA_WIDTH)
        y_c = jnp.concatenate([o_c * jax.nn.silu(g_mla[:, :c_]), r_c * jax.nn.silu(g_lru[:, :c_])], axis=-1) @ w_out
    return y_c, y_l


def _odd_mixer(h_c, h_l, w_in, rpb, w_out, need_ctx):
    b_, c_, _ = h_c.shape
    s_ = h_l.shape[1]
    rows = s_ // GRID_W
    wr = min(NA_WIN_R, rows)
    z = jnp.concatenate([h_c, h_l], axis=1) @ w_in
    def heads(t):
        return t.reshape(b_, t.shape[1], NA_HEADS, NA_HEAD_DIM).transpose(0, 2, 1, 3)
    q, k, v, g = jnp.split(z, 4, axis=-1)
    q, k, v = heads(q) * (NA_HEAD_DIM ** -0.5), heads(k), heads(v)
    q_c, k_c, v_c = q[:, :, :c_], k[:, :, :c_], v[:, :, :c_]
    q_grid = q[:, :, c_:].reshape(b_, NA_HEADS, rows, GRID_W, NA_HEAD_DIM)
    k_grid = k[:, :, c_:].reshape(b_, NA_HEADS, rows, GRID_W, NA_HEAD_DIM)
    v_grid = v[:, :, c_:].reshape(b_, NA_HEADS, rows, GRID_W, NA_HEAD_DIM)
    cols = jnp.arange(GRID_W)
    col_start = jnp.clip(cols - NA_WIN_C // 2, 0, GRID_W - NA_WIN_C)
    col_idx = col_start[:, None] + jnp.arange(NA_WIN_C)
    dc_idx = col_idx - cols[:, None] + (NA_WIN_C - 1)
    n_loc = wr * NA_WIN_C
    def row_block(args):
        r, q_row = args
        rs = jnp.clip(r - wr // 2, 0, rows - wr)
        k_rows = lax.dynamic_slice_in_dim(k_grid, rs, wr, axis=2)
        v_rows = lax.dynamic_slice_in_dim(v_grid, rs, wr, axis=2)
        k_win = k_rows[:, :, :, col_idx]
        v_win = v_rows[:, :, :, col_idx]
        dr_idx = rs + jnp.arange(wr) - r + (NA_WIN_R - 1)
        bias = rpb[:, dr_idx[None, :, None], dc_idx[:, None, :]]
        s_loc = jnp.einsum('bhqd,bhrqcd->bhqrc', q_row, k_win) + bias
        s_ctx = jnp.einsum('bhqd,bhkd->bhqk', q_row, k_c)
        s = jnp.concatenate([s_loc.reshape(b_, NA_HEADS, GRID_W, n_loc), s_ctx], axis=-1)
        p = jax.nn.softmax(s.astype(jnp.float32), axis=-1).astype(v.dtype)
        p_loc = p[..., :n_loc].reshape(b_, NA_HEADS, GRID_W, wr, NA_WIN_C)
        return (jnp.einsum('bhqrc,bhrqcd->bhqd', p_loc, v_win)
                + jnp.einsum('bhqk,bhkd->bhqd', p[..., n_loc:], v_c))
    o_l = lax.map(row_block, (jnp.arange(rows), jnp.moveaxis(q_grid, 2, 0)))
    o_l = o_l.transpose(1, 0, 3, 2, 4).reshape(b_, s_, NA_WIDTH)
    y_l = (o_l * jax.nn.silu(g[:, c_:])) @ w_out
    y_c = None
    if need_ctx:
        p_c = jax.nn.softmax(jnp.einsum('bhqd,bhkd->bhqk', q_c, k_c).astype(jnp.float32), axis=-1)
        o_c = jnp.einsum('bhqk,bhkd->bhqd', p_c.astype(v.dtype), v_c).transpose(0, 2, 1, 3).reshape(b_, c_, NA_WIDTH)
        y_c = (o_c * jax.nn.silu(g[:, :c_])) @ w_out
    return y_c, y_l


def setup_inputs(seed: int = 0) -> dict:
    key = jax.random.key(seed)
    ks = iter(jax.random.split(key, 32))
    def nrm(shape, s):
        return jax.random.normal(next(ks), shape, jnp.float32) * s
    u = jax.random.uniform(next(ks), (N_EVEN, 2, LRU_WIDTH), jnp.float32, 0.9, 0.999)
    log_a = jnp.log(u) / LRU_C
    lru_lambda = log_a - jnp.log(-jnp.expm1(log_a))
    return {
        'x': nrm((BATCH, SEQ, D_MODEL), 1.0),
        'c': nrm((BATCH, D_MODEL), 1.0),
        'ctx': nrm((BATCH, CTX_LEN, D_MODEL), 1.0),
        'c_ctx': nrm((D_MODEL,), 1.0),
        'ada_w': nrm((DEPTH, D_MODEL, 3 * D_MODEL), 0.5 * D_MODEL ** -0.5),
        'ada_b': nrm((DEPTH, 3 * D_MODEL), 0.01),
        'norm_g': 1.0 + nrm((DEPTH, D_MODEL), 0.01),
        'ev_w_in': nrm((N_EVEN, D_MODEL, EVEN_IN), D_MODEL ** -0.5),
        'mla_q_norm': 1.0 + nrm((N_EVEN, MLA_Q_RANK), 0.01),
        'mla_w_uq': nrm((N_EVEN, MLA_Q_RANK, MLA_HEADS * (MLA_NOPE + MLA_ROPE)), MLA_Q_RANK ** -0.5),
        'mla_kv_norm': 1.0 + nrm((N_EVEN, MLA_KV_RANK), 0.01),
        'mla_w_ukv': nrm((N_EVEN, MLA_KV_RANK, MLA_HEADS * (MLA_NOPE + MLA_V)), MLA_KV_RANK ** -0.5),
        'lru_conv_w': nrm((N_EVEN, LRU_CONV, LRU_WIDTH), LRU_CONV ** -0.5),
        'lru_conv_b': nrm((N_EVEN, LRU_WIDTH), 0.01),
        'lru_wa': nrm((N_EVEN, 2, LRU_BLOCKS, LRU_BLOCK, LRU_BLOCK), LRU_BLOCK ** -0.5),
        'lru_ba': nrm((N_EVEN, 2, LRU_WIDTH), 0.01),
        'lru_wx': nrm((N_EVEN, 2, LRU_BLOCKS, LRU_BLOCK, LRU_BLOCK), LRU_BLOCK ** -0.5),
        'lru_bx': nrm((N_EVEN, 2, LRU_WIDTH), 0.01),
        'lru_lambda': lru_lambda,
        'ev_w_out': nrm((N_EVEN, EVEN_MIX, D_MODEL), EVEN_MIX ** -0.5),
        'od_w_in': nrm((N_ODD, D_MODEL, ODD_IN), D_MODEL ** -0.5),
        'na_rpb': nrm((N_ODD, NA_HEADS, 2 * NA_WIN_R - 1, 2 * NA_WIN_C - 1), 0.1),
        'od_w_out': nrm((N_ODD, NA_WIDTH, D_MODEL), NA_WIDTH ** -0.5),
        'final_norm_g': 1.0 + nrm((D_MODEL,), 0.01),
    }


def reference(x, c, ctx, c_ctx, ada_w, ada_b, norm_g, ev_w_in, mla_q_norm, mla_w_uq,
              mla_kv_norm, mla_w_ukv, lru_conv_w, lru_conv_b, lru_wa, lru_ba, lru_wx, lru_bx,
              lru_lambda, ev_w_out, od_w_in, na_rpb, od_w_out, final_norm_g):
    tabs = _rope_2d_tables(x.shape[1])
    cx = ctx
    for layer in range(DEPTH):
        need_ctx = layer < DEPTH - 1
        shift, scale, gate = _adaln(c, ada_w[layer], ada_b[layer])
        shift_c, scale_c, gate_c = _adaln(c_ctx, ada_w[layer], ada_b[layer])
        h_l = _rmsnorm(x, norm_g[layer]) * (1.0 + scale[:, None]) + shift[:, None]
        h_c = _rmsnorm(cx, norm_g[layer]) * (1.0 + scale_c) + shift_c
        i = layer // 2
        if layer % 2 == 0:
            y_c, y_l = _even_mixer(h_c, h_l, ev_w_in[i], mla_q_norm[i], mla_w_uq[i], mla_kv_norm[i],
                                   mla_w_ukv[i], lru_conv_w[i], lru_conv_b[i], lru_wa[i], lru_ba[i],
                                   lru_wx[i], lru_bx[i], lru_lambda[i], ev_w_out[i], tabs, need_ctx)
        else:
            y_c, y_l = _odd_mixer(h_c, h_l, od_w_in[i], na_rpb[i], od_w_out[i], need_ctx)
        x = x + gate[:, None] * y_l
        if need_ctx:
            cx = cx + gate_c * y_c
    return _rmsnorm(x, final_norm_g)
```

```cpp
#include <hip/hip_runtime.h>
#include <hip/hip_cooperative_groups.h>
#include <cstdio>
namespace cg = cooperative_groups;

#define DI __device__ __forceinline__
typedef unsigned short u16;
using bf16x8 = __attribute__((ext_vector_type(8))) short;
using s16x4  = __attribute__((ext_vector_type(4))) short;
using f32x16 = __attribute__((ext_vector_type(16))) float;
typedef __bf16 bf2_t __attribute__((ext_vector_type(2)));
typedef float fl2_t __attribute__((ext_vector_type(2)));

#ifndef NLAYERS_RUN
#define NLAYERS_RUN 4
#endif

constexpr int D = 1024, NB = 4, SEQ = 8192, CTX = 256, TB = SEQ + CTX, M = NB * TB;
constexpr int NCH = TB / 64;
constexpr float LOG2E = 1.4426950408889634f;
constexpr float MLA_QS = 0.10206207261596575f * LOG2E;
constexpr float RMS_EPS = 1e-6f;

constexpr size_t SZ_WINE = (size_t)2048 * 1024 * 2, SZ_WUQ = (size_t)768 * 256 * 2, SZ_WUKV = (size_t)1024 * 128 * 2;
constexpr size_t SZ_WOUT = (size_t)1024 * 1024 * 2, SZ_WINO = (size_t)4096 * 1024 * 2, SZ_WLRU = (size_t)32 * 4096 * 2;
constexpr size_t OFF_WINE = 0;
constexpr size_t OFF_WUQ = OFF_WINE + 2 * SZ_WINE;
constexpr size_t OFF_WUKV = OFF_WUQ + 2 * SZ_WUQ;
constexpr size_t OFF_WOUTE = OFF_WUKV + 2 * SZ_WUKV;
constexpr size_t OFF_WINO = OFF_WOUTE + 2 * SZ_WOUT;
constexpr size_t OFF_WOUTO = OFF_WINO + 2 * SZ_WINO;
constexpr size_t OFF_WA = OFF_WOUTO + 2 * SZ_WOUT;
constexpr size_t OFF_WX = OFF_WA + SZ_WLRU;
constexpr size_t OFF_MOD = OFF_WX + SZ_WLRU;
constexpr size_t SZ_MOD = (size_t)4 * 5 * 3072 * 4;
constexpr size_t OFF_CX = OFF_MOD + SZ_MOD;
constexpr size_t SZ_CX = (size_t)NB * CTX * D * 4;
constexpr size_t OFF_H = OFF_CX + SZ_CX;
constexpr size_t SZ_H = (size_t)M * D * 2;
constexpr size_t OFF_Z = OFF_H + SZ_H;
constexpr size_t OFF_ZE = OFF_Z;
constexpr size_t SZ_ZE = (size_t)M * 2048 * 2;
constexpr size_t OFF_Q = OFF_ZE + SZ_ZE;
constexpr size_t SZ_Q = (size_t)NB * 8 * TB * 96 * 2;
constexpr size_t OFF_KN = OFF_Q + SZ_Q;
constexpr size_t SZ_KN = (size_t)NB * 8 * TB * 64 * 2;
constexpr size_t OFF_KR = OFF_KN + SZ_KN;
constexpr size_t SZ_KR = (size_t)NB * TB * 32 * 2;
constexpr size_t OFF_VTE = OFF_KR + SZ_KR;
constexpr size_t SZ_VTE = (size_t)NB * 8 * 64 * TB * 2;
constexpr size_t OFF_AGGA = OFF_VTE + SZ_VTE;
constexpr size_t SZ_AGG = (size_t)NB * NCH * 2 * 512 * 4;
constexpr size_t OFF_AGGH = OFF_AGGA + SZ_AGG;
constexpr size_t END_EVEN = OFF_AGGH + SZ_AGG;
constexpr size_t OFF_ZO = OFF_Z;
constexpr size_t SZ_ZO = (size_t)M * 3072 * 2;
constexpr size_t OFF_VTO = OFF_ZO + SZ_ZO;
constexpr size_t SZ_VTO = (size_t)NB * 16 * 64 * TB * 2;
constexpr size_t END_ODD = OFF_VTO + SZ_VTO;
constexpr size_t OFF_BAR = END_EVEN > END_ODD ? END_EVEN : END_ODD;
constexpr size_t OFF_XB = OFF_BAR + 16384;
constexpr size_t WS_NEED = OFF_XB + (size_t)M * D * 2;

struct Params {
  const float *x, *c, *ctx, *c_ctx, *ada_w, *ada_b, *norm_g, *ev_w_in, *q_norm, *w_uq, *kv_norm, *w_ukv;
  const float *conv_w, *conv_b, *wa, *ba, *wx, *bx, *lam, *ev_w_out, *od_w_in, *rpb, *od_w_out, *fin_g;
  float* out;
  char* ws;
};

DI int ltid() { int t = threadIdx.x; asm volatile("" : "+v"(t)); return t; }
DI int lbid() { int t = blockIdx.x; asm volatile("" : "+s"(t)); return t; }
DI unsigned pk2(float a, float b) { fl2_t f = {a, b}; bf2_t r = __builtin_convertvector(f, bf2_t); return __builtin_bit_cast(unsigned, r); }
DI u16 f2bf(float a) { return (u16)(pk2(a, a) & 0xffffu); }
DI float bf2f(u16 v) { return __uint_as_float(((unsigned)v) << 16); }
DI float bflo(unsigned w) { return __uint_as_float(w << 16); }
DI float bfhi(unsigned w) { return __uint_as_float(w & 0xffff0000u); }
DI f32x16 mfma32(bf16x8 a, bf16x8 b, f32x16 c) { return __builtin_amdgcn_mfma_f32_32x32x16_bf16(a, b, c, 0, 0, 0); }
DI int crow(int i, int h) { return (i & 3) + 8 * (i >> 2) + 4 * h; }
DI float silu(float g) { return g * __builtin_amdgcn_rcpf(1.f + __expf(-g)); }
DI float sigmoidf(float g) { return __builtin_amdgcn_rcpf(1.f + __expf(-g)); }
DI float swapmax(float v) { auto rr = __builtin_amdgcn_permlane32_swap(__float_as_uint(v), __float_as_uint(v), false, false);
  return fmaxf(__uint_as_float(rr[0]), __uint_as_float(rr[1])); }
DI float swapsum(float v) { auto rr = __builtin_amdgcn_permlane32_swap(__float_as_uint(v), __float_as_uint(v), false, false);
  return __uint_as_float(rr[0]) + __uint_as_float(rr[1]); }
DI float wave_sum(float v) {
#pragma unroll
  for (int o = 32; o >= 1; o >>= 1) v += __shfl_xor(v, o);
  return v; }
DI bf16x8 pack8(float a0, float a1, float a2, float a3, float a4, float a5, float a6, float a7) {
  uint4 w = {pk2(a0, a1), pk2(a2, a3), pk2(a4, a5), pk2(a6, a7)}; return __builtin_bit_cast(bf16x8, w); }

constexpr int GLD = 72;
template <bool SUMSQ>
DI void gemm_core(const u16* __restrict__ P, int ldp, const u16* __restrict__ Q, int ldq, int K,
                  u16* sP, u16* sQ, f32x16 (&acc)[2][2], float (&ss)[2]) {
  const int tid = ltid(), lane = tid & 63, wid = tid >> 6, r = lane & 31, h = lane >> 5, wm = wid >> 1, wn = wid & 1;
  const int lr = tid >> 3, lc = (tid & 7) * 8;
  uint4 rp0, rp1, rp2, rp3, rq0, rq1, rq2, rq3;
#pragma unroll
  for (int a = 0; a < 2; ++a)
#pragma unroll
    for (int b = 0; b < 2; ++b)
#pragma unroll
      for (int i = 0; i < 16; ++i) acc[a][b][i] = 0.f;
  ss[0] = 0.f; ss[1] = 0.f;
  const u16* Pg = P + (size_t)lr * ldp + lc;
  const u16* Qg = Q + (size_t)lr * ldq + lc;
#define GLOADPQ(KO) do { \
    rp0 = *(const uint4*)(Pg + (KO)); rp1 = *(const uint4*)(Pg + (size_t)32 * ldp + (KO)); \
    rp2 = *(const uint4*)(Pg + (size_t)64 * ldp + (KO)); rp3 = *(const uint4*)(Pg + (size_t)96 * ldp + (KO)); \
    rq0 = *(const uint4*)(Qg + (KO)); rq1 = *(const uint4*)(Qg + (size_t)32 * ldq + (KO)); \
    rq2 = *(const uint4*)(Qg + (size_t)64 * ldq + (KO)); rq3 = *(const uint4*)(Qg + (size_t)96 * ldq + (KO)); } while (0)
  GLOADPQ(0);
  for (int k0 = 0; k0 < K; k0 += 64) {
    __syncthreads();
    *(uint4*)(sP + (lr) * GLD + lc) = rp0; *(uint4*)(sP + (lr + 32) * GLD + lc) = rp1;
    *(uint4*)(sP + (lr + 64) * GLD + lc) = rp2; *(uint4*)(sP + (lr + 96) * GLD + lc) = rp3;
    *(uint4*)(sQ + (lr) * GLD + lc) = rq0; *(uint4*)(sQ + (lr + 32) * GLD + lc) = rq1;
    *(uint4*)(sQ + (lr + 64) * GLD + lc) = rq2; *(uint4*)(sQ + (lr + 96) * GLD + lc) = rq3;
    __syncthreads();
    if (k0 + 64 < K) GLOADPQ(k0 + 64);
#pragma unroll
    for (int s = 0; s < 4; ++s) {
      const bf16x8 a0 = *(const bf16x8*)(sP + (wm * 64 + r) * GLD + s * 16 + h * 8);
      const bf16x8 a1 = *(const bf16x8*)(sP + (wm * 64 + 32 + r) * GLD + s * 16 + h * 8);
      const bf16x8 b0 = *(const bf16x8*)(sQ + (wn * 64 + r) * GLD + s * 16 + h * 8);
      const bf16x8 b1 = *(const bf16x8*)(sQ + (wn * 64 + 32 + r) * GLD + s * 16 + h * 8);
      if (SUMSQ) {
#pragma unroll
        for (int j = 0; j < 8; ++j) { float f0 = bf2f((u16)b0[j]), f1 = bf2f((u16)b1[j]); ss[0] += f0 * f0; ss[1] += f1 * f1; }
      }
      acc[0][0] = mfma32(a0, b0, acc[0][0]); acc[0][1] = mfma32(a0, b1, acc[0][1]);
      acc[1][0] = mfma32(a1, b0, acc[1][0]); acc[1][1] = mfma32(a1, b1, acc[1][1]);
    }
  }
}

DI void epi_store_rows(const f32x16 (&acc)[2][2], u16* C, int ldc, int m0, int n0, int nvalid) {
  const int tid = ltid(), lane = tid & 63, wid = tid >> 6, r = lane & 31, h = lane >> 5, wm = wid >> 1, wn = wid & 1;
#pragma unroll
  for (int ni = 0; ni < 2; ++ni) {
    const int nb = n0 + wn * 64 + ni * 32;
    if (nb >= nvalid) continue;
    const int odd = r & 1;
#pragma unroll
    for (int mi = 0; mi < 2; ++mi)
#pragma unroll
      for (int i = 0; i < 16; i += 2) {
        const float mine0 = acc[mi][ni][i], mine1 = acc[mi][ni][i + 1];
        const float got = __shfl_xor(odd ? mine0 : mine1, 1);
        const unsigned w = odd ? pk2(got, mine1) : pk2(mine0, got);
        const int m = m0 + wm * 64 + mi * 32 + crow(i, h) + odd;
        *(unsigned*)(C + (size_t)m * ldc + nb + (r & ~1)) = w;
      }
  }
}
DI void epi_store_vt(const f32x16 (&acc)[2][2], u16* Vt, int nheads, int m0, int nn0) {
  const int tid = ltid(), lane = tid & 63, wid = tid >> 6, r = lane & 31, h = lane >> 5, wm = wid >> 1, wn = wid & 1;
  const int b = m0 / TB, tb0 = m0 % TB;
#pragma unroll
  for (int ni = 0; ni < 2; ++ni) {
    const int nn = nn0 + wn * 64 + ni * 32 + r, hd = nn >> 6, d = nn & 63;
    u16* base = Vt + ((size_t)(b * nheads + hd) * 64 + d) * TB + tb0 + wm * 64 + 4 * h;
#pragma unroll
    for (int mi = 0; mi < 2; ++mi)
#pragma unroll
      for (int g = 0; g < 4; ++g) {
        uint2 w = {pk2(acc[mi][ni][4 * g], acc[mi][ni][4 * g + 1]), pk2(acc[mi][ni][4 * g + 2], acc[mi][ni][4 * g + 3])};
        *(uint2*)(base + mi * 32 + 8 * g) = w;
      }
  }
}

DI void prep_tile(const float* __restrict__ src, int lds_, int nsrc, int k0, int n0, u16* __restrict__ dst, int K, int dn0,
                  const float* __restrict__ rowscale, float cscale, float* sT) {
  const int tid = ltid();
#pragma unroll
  for (int i = 0; i < 4; ++i) {
    const int idx = tid + 256 * i, kk = idx >> 4, n4 = (idx & 15) * 4;
    const bool ok = n0 + n4 < nsrc;
    float4 v = *(const float4*)(src + (size_t)(k0 + kk) * lds_ + (ok ? n0 + n4 : 0));
    if (!ok) v = make_float4(0.f, 0.f, 0.f, 0.f);
    const float sc = cscale * (rowscale ? rowscale[k0 + kk] : 1.f);
    sT[(n4 + 0) * 65 + kk] = v.x * sc; sT[(n4 + 1) * 65 + kk] = v.y * sc; sT[(n4 + 2) * 65 + kk] = v.z * sc; sT[(n4 + 3) * 65 + kk] = v.w * sc;
  }
  __syncthreads();
#pragma unroll
  for (int i = 0; i < 2; ++i) {
    const int idx = tid + 256 * i, n = idx >> 3, c = (idx & 7) * 8;
    const float* s = sT + n * 65 + c;
    uint4 w = {pk2(s[0], s[1]), pk2(s[2], s[3]), pk2(s[4], s[5]), pk2(s[6], s[7])};
    *(uint4*)(dst + (size_t)(dn0 + n) * K + k0 + c) = w;
  }
  __syncthreads();
}

DI void phase_prep(const Params& p, char* smem) {
  const int tid = ltid(), lane = tid & 63, wid = tid >> 6;
  constexpr int NADA = 192, PER_I = 512 + 48 + 32 + 256 + 1024 + 256, NTOT = NADA + 2 * PER_I + 64;
  for (int it = lbid(); it < NTOT; it += gridDim.x) {
    if (it < NADA) {
      const int layer = it / 48, j = (it % 48) * 64 + lane;
      float* sCond = (float*)smem;
      float* sRed = sCond + 5 * 1024;
      for (int e = tid; e < 5 * 1024; e += 256) { const float v = e < 4096 ? p.c[e] : p.c_ctx[e - 4096]; sCond[e] = silu(v); }
      __syncthreads();
      float a0 = 0.f, a1 = 0.f, a2 = 0.f, a3 = 0.f, a4 = 0.f;
      const float* w = p.ada_w + ((size_t)layer * 1024 + wid * 256) * 3072 + j;
      const float* sc = sCond + wid * 256;
#pragma unroll 8
      for (int k = 0; k < 256; ++k) {
        const float wv = w[(size_t)k * 3072];
        a0 += sc[k] * wv; a1 += sc[1024 + k] * wv; a2 += sc[2048 + k] * wv; a3 += sc[3072 + k] * wv; a4 += sc[4096 + k] * wv;
      }
      sRed[(wid * 5 + 0) * 64 + lane] = a0; sRed[(wid * 5 + 1) * 64 + lane] = a1; sRed[(wid * 5 + 2) * 64 + lane] = a2;
      sRed[(wid * 5 + 3) * 64 + lane] = a3; sRed[(wid * 5 + 4) * 64 + lane] = a4;
      __syncthreads();
      if (tid < 64) {
        float* mod = (float*)(p.ws + OFF_MOD);
        const float bias = p.ada_b[layer * 3072 + j];
#pragma unroll
        for (int rw = 0; rw < 5; ++rw) {
          const float s = sRed[(0 * 5 + rw) * 64 + lane] + sRed[(1 * 5 + rw) * 64 + lane] + sRed[(2 * 5 + rw) * 64 + lane] + sRed[(3 * 5 + rw) * 64 + lane];
          mod[((size_t)layer * 5 + rw) * 3072 + j] = s + bias;
        }
      }
      __syncthreads();
      continue;
    }
    int q = it - NADA;
    float* sT = (float*)smem;
    if (q < 2 * PER_I) {
      const int i = q / PER_I; q -= i * PER_I;
      if (q < 512) {
        const int kt = q & 15, nt = q >> 4;
        prep_tile(p.ev_w_in + (size_t)i * 1024 * 1952, 1952, 1952, kt * 64, nt * 64, (u16*)(p.ws + OFF_WINE + i * SZ_WINE), 1024, nt * 64, nullptr, 1.f, sT);
      } else if (q < 560) {
        q -= 512; const int kt = q & 3, nt = q >> 2;
        prep_tile(p.w_uq + (size_t)i * 256 * 768, 768, 768, kt * 64, nt * 64, (u16*)(p.ws + OFF_WUQ + i * SZ_WUQ), 256, nt * 64, p.q_norm + i * 256, 1.f, sT);
      } else if (q < 592) {
        q -= 560; const int kt = q & 1, nt = q >> 1;
        prep_tile(p.w_ukv + (size_t)i * 128 * 1024, 1024, 1024, kt * 64, nt * 64, (u16*)(p.ws + OFF_WUKV + i * SZ_WUKV), 128, nt * 64, p.kv_norm + i * 128, 1.f, sT);
      } else if (q < 848) {
        q -= 592; const int kt = q & 15, nt = q >> 4;
        prep_tile(p.ev_w_out + (size_t)i * 1024 * 1024, 1024, 1024, kt * 64, nt * 64, (u16*)(p.ws + OFF_WOUTE + i * SZ_WOUT), 1024, nt * 64, nullptr, 1.f, sT);
      } else if (q < 1872) {
        q -= 848; const int kt = q & 15, nt = q >> 4;
        const int n0 = nt * 64, reg = n0 >> 10;
        const int dn0 = (reg == 2 ? 3072 : reg == 3 ? 2048 : reg * 1024) + (n0 & 1023);
        prep_tile(p.od_w_in + (size_t)i * 1024 * 4096, 4096, 4096, kt * 64, n0, (u16*)(p.ws + OFF_WINO + i * SZ_WINO), 1024, dn0, nullptr, reg == 0 ? 0.125f * LOG2E : 1.f, sT);
      } else {
        q -= 1872; const int kt = q & 15, nt = q >> 4;
        prep_tile(p.od_w_out + (size_t)i * 1024 * 1024, 1024, 1024, kt * 64, nt * 64, (u16*)(p.ws + OFF_WOUTO + i * SZ_WOUT), 1024, nt * 64, nullptr, 1.f, sT);
      }
    } else {
      q -= 2 * PER_I;
      if (q < 32) prep_tile(p.wa + (size_t)q * 4096, 64, 64, 0, 0, (u16*)(p.ws + OFF_WA) + (size_t)q * 4096, 64, 0, nullptr, 1.f, sT);
      else { q -= 32; prep_tile(p.wx + (size_t)q * 4096, 64, 64, 0, 0, (u16*)(p.ws + OFF_WX) + (size_t)q * 4096, 64, 0, nullptr, 1.f, sT); }
    }
  }
}

DI const float* resid_in(const Params& p, int L, int b, int t) {
  if (t < CTX) return (L == 0 ? p.ctx : (const float*)(p.ws + OFF_CX)) + ((size_t)b * CTX + t) * D;
  return (L == 0 ? p.x : (const float*)p.out) + ((size_t)b * SEQ + (t - CTX)) * D;
}
DI float* resid_out(const Params& p, int b, int t) {
  if (t < CTX) return (float*)(p.ws + OFF_CX) + ((size_t)b * CTX + t) * D;
  return p.out + ((size_t)b * SEQ + (t - CTX)) * D;
}

DI void phase_norm(const Params& p, int L) {
  const int tid = ltid(), lane = tid & 63, wid = tid >> 6;
  const float* mod = (const float*)(p.ws + OFF_MOD);
  u16* hbuf = (u16*)(p.ws + OFF_H);
  for (int it = lbid(); it < M / 4; it += gridDim.x) {
    const int m = it * 4 + wid, b = m / TB, t = m % TB, mrow = t < CTX ? 4 : b;
    float4 v[4]; float ssq = 0.f;
    if (L == 0) {
      const float4* src = (const float4*)resid_in(p, 0, b, t);
#pragma unroll
      for (int j = 0; j < 4; ++j) v[j] = src[lane + 64 * j];
    } else {
      const uint2* src = (const uint2*)((const u16*)(p.ws + OFF_XB) + (size_t)m * 1024);
#pragma unroll
      for (int j = 0; j < 4; ++j) { const uint2 w = src[lane + 64 * j]; v[j] = make_float4(bflo(w.x), bfhi(w.x), bflo(w.y), bfhi(w.y)); }
    }
#pragma unroll
    for (int j = 0; j < 4; ++j) ssq += v[j].x * v[j].x + v[j].y * v[j].y + v[j].z * v[j].z + v[j].w * v[j].w;
    ssq = wave_sum(ssq);
    const float rs = rsqrtf(ssq * (1.f / 1024.f) + RMS_EPS);
    const float4* g4 = (const float4*)(p.norm_g + L * 1024);
    const float4* sh4 = (const float4*)(mod + ((size_t)L * 5 + mrow) * 3072);
    const float4* sc4 = sh4 + 256;
#pragma unroll
    for (int j = 0; j < 4; ++j) {
      const int k4 = lane + 64 * j;
      const float4 g = g4[k4], sh = sh4[k4], sc = sc4[k4];
      const float y0 = v[j].x * rs * g.x * (1.f + sc.x) + sh.x, y1 = v[j].y * rs * g.y * (1.f + sc.y) + sh.y;
      const float y2 = v[j].z * rs * g.z * (1.f + sc.z) + sh.z, y3 = v[j].w * rs * g.w * (1.f + sc.w) + sh.w;
      uint2 w = {pk2(y0, y1), pk2(y2, y3)};
      *(uint2*)(hbuf + (size_t)m * 1024 + k4 * 4) = w;
    }
  }
}

DI void phase_final_norm(const Params& p) {
  const int tid = ltid(), lane = tid & 63, wid = tid >> 6;
  for (int it = lbid(); it < NB * SEQ / 4; it += gridDim.x) {
    const int m = it * 4 + wid;
    float4* row = (float4*)(p.out + (size_t)m * 1024);
    float4 v[4]; float ssq = 0.f;
#pragma unroll
    for (int j = 0; j < 4; ++j) { v[j] = row[lane + 64 * j]; ssq += v[j].x * v[j].x + v[j].y * v[j].y + v[j].z * v[j].z + v[j].w * v[j].w; }
    ssq = wave_sum(ssq);
    const float rs = rsqrtf(ssq * (1.f / 1024.f) + RMS_EPS);
    const float4* g4 = (const float4*)p.fin_g;
#pragma unroll
    for (int j = 0; j < 4; ++j) {
      const float4 g = g4[lane + 64 * j];
      row[lane + 64 * j] = make_float4(v[j].x * rs * g.x, v[j].y * rs * g.y, v[j].z * rs * g.z, v[j].w * rs * g.w);
    }
  }
}

DI void phase_win_even(const Params& p, int li, char* smem) {
  u16* sP = (u16*)smem; u16* sQ = sP + 128 * GLD;
  const u16* A = (const u16*)(p.ws + OFF_H);
  const u16* W = (const u16*)(p.ws + OFF_WINE + li * SZ_WINE);
  u16* Z = (u16*)(p.ws + OFF_ZE);
  for (int it = lbid(); it < (M / 128) * 16; it += gridDim.x) {
    const int mt = it >> 4, nt = it & 15;
    f32x16 acc[2][2]; float ss[2];
    gemm_core<false>(A + (size_t)mt * 128 * 1024, 1024, W + (size_t)nt * 128 * 1024, 1024, 1024, sP, sQ, acc, ss);
    epi_store_rows(acc, Z, 2048, mt * 128, nt * 128, 1952);
  }
}
DI void phase_win_odd(const Params& p, int li, char* smem) {
  u16* sP = (u16*)smem; u16* sQ = sP + 128 * GLD;
  const u16* A = (const u16*)(p.ws + OFF_H);
  const u16* W = (const u16*)(p.ws + OFF_WINO + li * SZ_WINO);
  u16* Z = (u16*)(p.ws + OFF_ZO);
  u16* Vt = (u16*)(p.ws + OFF_VTO);
  for (int it = lbid(); it < (M / 128) * 32; it += gridDim.x) {
    const int mt = it >> 5, nt = it & 31;
    f32x16 acc[2][2]; float ss[2];
    gemm_core<false>(A + (size_t)mt * 128 * 1024, 1024, W + (size_t)nt * 128 * 1024, 1024, 1024, sP, sQ, acc, ss);
    if (nt < 24) epi_store_rows(acc, Z, 3072, mt * 128, nt * 128, 3072);
    else epi_store_vt(acc, Vt, 16, mt * 128, nt * 128 - 3072);
  }
}

DI void phase_out(const Params& p, int L, char* smem, bool dry = false) {
  u16* sP = (u16*)smem; u16* sQ = sP + 128 * GLD;
  const int li = L >> 1;
  const u16* A = (const u16*)(p.ws + OFF_H);
  const u16* W = (const u16*)(p.ws + ((L & 1) ? OFF_WOUTO : OFF_WOUTE) + li * SZ_WOUT);
  const float* mod = (const float*)(p.ws + OFF_MOD);
  const int tid = ltid(), lane = tid & 63, wid = tid >> 6, r = lane & 31, h = lane >> 5, wm = wid >> 1, wn = wid & 1;
  for (int it = lbid(); it < (M / 128) * 8; it += gridDim.x) {
    const int mt = it >> 3, nt = it & 7;
    const int m0 = mt * 128, b = m0 / TB, tb0 = m0 % TB;
    const bool isctx = tb0 < CTX;
    if (isctx && L == 3) continue;
    f32x16 acc[2][2]; float ss[2];
    gemm_core<false>(A + (size_t)m0 * 1024, 1024, W + (size_t)nt * 128 * 1024, 1024, 1024, sP, sQ, acc, ss);
    const float* rin32 = resid_in(p, 0, b, tb0);
    u16* xb = (u16*)(p.ws + (dry ? OFF_Z : OFF_XB)) + (size_t)m0 * 1024;
    const u16* xin = (const u16*)(p.ws + OFF_XB) + (size_t)m0 * 1024;
    float* rout32 = p.out + ((size_t)b * SEQ + (tb0 - CTX)) * D;
    const float* gate = mod + ((size_t)L * 5 + (isctx ? 4 : b)) * 3072 + 2048;
#pragma unroll
    for (int ni = 0; ni < 2; ++ni) {
      const int n = nt * 128 + wn * 64 + ni * 32 + r;
      const float gt = gate[n];
#pragma unroll
      for (int mi = 0; mi < 2; ++mi)
#pragma unroll
        for (int i = 0; i < 16; ++i) {
          const size_t o = (size_t)(wm * 64 + mi * 32 + crow(i, h)) * 1024 + n;
          const float xv = L == 0 ? rin32[o] : bf2f(xin[o]);
          const float y = xv + gt * acc[mi][ni][i];
          if (L == 3 && !dry) rout32[o] = y; else xb[o] = f2bf(y);
        }
    }
  }
}

DI void qproj_tile(const Params& p, int li, int mt, int nt, char* smem) {
  u16* sP = (u16*)smem; u16* sQ = sP + 128 * GLD;
  const int tid = ltid(), lane = tid & 63, wid = tid >> 6, r = lane & 31, h = lane >> 5, wm = wid >> 1, wn = wid & 1;
  const u16* W = (const u16*)(p.ws + OFF_WUQ + li * SZ_WUQ);
  const u16* Z = (const u16*)(p.ws + OFF_ZE);
  u16* Qb = (u16*)(p.ws + OFF_Q);
  f32x16 acc[2][2]; float ss[2];
  gemm_core<true>(W + (size_t)nt * 128 * 256, 256, Z + (size_t)mt * 128 * 2048, 2048, 256, sP, sQ, acc, ss);
#pragma unroll
  for (int ni = 0; ni < 2; ++ni) {
    const float rs = rsqrtf(swapsum(ss[ni]) * (1.f / 256.f) + RMS_EPS);
    const int m = mt * 128 + wn * 64 + ni * 32 + r, b = m / TB, t = m % TB;
    const int pos = t - CTX;
    const float prow = (float)(pos >> 6), pcol = (float)(pos & 63);
#pragma unroll
    for (int mi = 0; mi < 2; ++mi) {
      const int gt = (nt * 128 + wm * 64 + mi * 32) >> 5, hd = gt / 3, part = gt % 3;
      float v[16];
#pragma unroll
      for (int i = 0; i < 16; ++i) v[i] = acc[mi][ni][i] * rs;
      if (part == 2 && t >= CTX) {
#pragma unroll
        for (int i = 0; i < 4; ++i) {
          const float inv = exp2f(-(float)(4 * h + i) * 1.6609640474436813f);
          float ar = prow * inv, ac = pcol * inv;
          const float cr = __cosf(ar), sr = __sinf(ar), cc = __cosf(ac), sc = __sinf(ac);
          const float x1 = v[i], x2 = v[i + 4], y1 = v[8 + i], y2 = v[12 + i];
          v[i] = x1 * cr - x2 * sr; v[i + 4] = x2 * cr + x1 * sr;
          v[8 + i] = y1 * cc - y2 * sc; v[12 + i] = y2 * cc + y1 * sc;
        }
      }
      u16* dst = Qb + ((size_t)(b * 8 + hd) * TB + t) * 96 + part * 32 + 4 * h;
#pragma unroll
      for (int g = 0; g < 4; ++g) {
        uint2 w = {pk2(v[4 * g] * MLA_QS, v[4 * g + 1] * MLA_QS), pk2(v[4 * g + 2] * MLA_QS, v[4 * g + 3] * MLA_QS)};
        *(uint2*)(dst + 8 * g) = w;
      }
    }
  }
}
DI void kvproj_tile(const Params& p, int li, int mt, int nt, char* smem) {
  u16* sP = (u16*)smem; u16* sQ = sP + 128 * GLD;
  const int tid = ltid(), lane = tid & 63, wid = tid >> 6, r = lane & 31, h = lane >> 5, wm = wid >> 1, wn = wid & 1;
  const u16* W = (const u16*)(p.ws + OFF_WUKV + li * SZ_WUKV);
  const u16* Z = (const u16*)(p.ws + OFF_ZE);
  u16* Kn = (u16*)(p.ws + OFF_KN);
  u16* Vt = (u16*)(p.ws + OFF_VTE);
  f32x16 acc[2][2]; float ss[2];
  gemm_core<true>(W + (size_t)nt * 128 * 128, 128, Z + (size_t)mt * 128 * 2048 + 256, 2048, 128, sP, sQ, acc, ss);
#pragma unroll
  for (int ni = 0; ni < 2; ++ni) {
    const float rs = rsqrtf(swapsum(ss[ni]) * (1.f / 128.f) + RMS_EPS);
    const int m = mt * 128 + wn * 64 + ni * 32 + r, b = m / TB, t = m % TB;
#pragma unroll
    for (int mi = 0; mi < 2; ++mi) {
      const int gt = (nt * 128 + wm * 64 + mi * 32) >> 5, hd = gt >> 2, part = gt & 3;
      if (part < 2) {
        u16* dst = Kn + ((size_t)(b * 8 + hd) * TB + t) * 64 + part * 32 + 4 * h;
#pragma unroll
        for (int g = 0; g < 4; ++g) {
          uint2 w = {pk2(acc[mi][ni][4 * g] * rs, acc[mi][ni][4 * g + 1] * rs), pk2(acc[mi][ni][4 * g + 2] * rs, acc[mi][ni][4 * g + 3] * rs)};
          *(uint2*)(dst + 8 * g) = w;
        }
      } else {
        u16* dst = Vt + ((size_t)(b * 8 + hd) * 64 + (part - 2) * 32) * TB + t;
#pragma unroll
        for (int i = 0; i < 16; ++i) dst[(size_t)crow(i, h) * TB] = f2bf(acc[mi][ni][i] * rs);
      }
    }
  }
}
DI void krope_item(const Params& p, int it) {
  const int tid = ltid();
  const int m = it * 16 + (tid >> 4), f = tid & 15, blk = f >> 3, fi = f & 7;
  const int t = m % TB;
  const u16* src = (const u16*)(p.ws + OFF_ZE) + (size_t)m * 2048 + 384 + 16 * blk + fi;
  u16* dst = (u16*)(p.ws + OFF_KR) + (size_t)m * 32 + 16 * blk + fi;
  float x1 = bf2f(src[0]), x2 = bf2f(src[8]);
  if (t >= CTX) {
    const int pos = t - CTX;
    const float ang = (float)(blk ? (pos & 63) : (pos >> 6)) * exp2f(-(float)fi * 1.6609640474436813f);
    const float c = __cosf(ang), s = __sinf(ang);
    const float y1 = x1 * c - x2 * s, y2 = x2 * c + x1 * s;
    x1 = y1; x2 = y2;
  }
  dst[0] = f2bf(x1); dst[8] = f2bf(x2);
}

constexpr int LRU_SU = 0, LRU_SA = 64 * 72 * 2, LRU_SUU = LRU_SA + 2 * 64 * 64 * 4, LRU_SMEM = LRU_SUU + 2 * 64 * 64 * 2;
template <int PASS>
DI void lru_item(const Params& p, int li, int it, char* smem) {
  const int tid = ltid(), lane = tid & 63, wid = tid >> 6, r = lane & 31, h = lane >> 5;
  const int n = it & 7, j = (it >> 3) % NCH, b = it / (8 * NCH);
  const int t0 = j * 64, seg_lo = j < 4 ? 0 : CTX, seg_hi = j < 4 ? CTX : TB;
  u16* sU = (u16*)(smem + LRU_SU);
  float* sA = (float*)(smem + LRU_SA);
  u16* sUU = (u16*)(smem + LRU_SUU);
  const u16* zE = (const u16*)(p.ws + OFF_ZE);
  {
    const int c = tid & 63, tg = tid >> 6, gc = n * 64 + c;
    const u16* zcol = zE + (size_t)b * TB * 2048 + 928 + gc;
    const float* cw = p.conv_w + (size_t)li * 4 * 512 + gc;
    const float w0 = cw[0], w1 = cw[512], w2 = cw[1024], w3 = cw[1536], cb = p.conv_b[li * 512 + gc];
    const int tb = t0 + tg * 16;
    auto ld = [&](int t) -> float { return (t >= seg_lo && t < seg_hi) ? bf2f(zcol[(size_t)t * 2048]) : 0.f; };
    float xm2 = ld(tb - 2), xm1 = ld(tb - 1), x0 = ld(tb);
#pragma unroll
    for (int tt = 0; tt < 16; ++tt) {
      const float xp1 = ld(tb + tt + 1);
      const float u = w0 * xm2 + w1 * xm1 + w2 * x0 + w3 * xp1 + cb;
      sU[(tg * 16 + tt) * 72 + c] = f2bf(u);
      xm2 = xm1; xm1 = x0; x0 = xp1;
    }
  }
  __syncthreads();
  {
    const int mi = wid >> 1, ni = wid & 1;
    f32x16 acc[2][2];
#pragma unroll
    for (int d = 0; d < 2; ++d)
#pragma unroll
      for (int q = 0; q < 2; ++q)
#pragma unroll
        for (int i = 0; i < 16; ++i) acc[d][q][i] = 0.f;
    const u16* WA = (const u16*)(p.ws + OFF_WA) + ((size_t)(li * 2) * 8 + n) * 4096 + (ni * 32 + r) * 64 + 8 * h;
    const u16* WX = (const u16*)(p.ws + OFF_WX) + ((size_t)(li * 2) * 8 + n) * 4096 + (ni * 32 + r) * 64 + 8 * h;
#pragma unroll
    for (int s = 0; s < 4; ++s) {
      const bf16x8 af = *(const bf16x8*)(sU + (mi * 32 + r) * 72 + 16 * s + 8 * h);
#pragma unroll
      for (int d = 0; d < 2; ++d) {
        const bf16x8 wa = *(const bf16x8*)(WA + (size_t)d * 8 * 4096 + 16 * s);
        const bf16x8 wx = *(const bf16x8*)(WX + (size_t)d * 8 * 4096 + 16 * s);
        acc[d][0] = mfma32(af, wa, acc[d][0]);
        acc[d][1] = mfma32(af, wx, acc[d][1]);
      }
    }
    const int cc = ni * 32 + r, gc = n * 64 + cc;
#pragma unroll
    for (int d = 0; d < 2; ++d) {
      const int pi = (li * 2 + d) * 512 + gc;
      const float ba = p.ba[pi], bx = p.bx[pi], lam = p.lam[pi];
      const float sp = log1pf(__expf(-lam));
#pragma unroll
      for (int i = 0; i < 16; ++i) {
        const int tl = mi * 32 + crow(i, h);
        const float rr = sigmoidf(acc[d][0][i] + ba), ii = sigmoidf(acc[d][1][i] + bx);
        const float la = -8.f * rr * sp;
        const float a = __expf(la);
        const float x2 = 2.f * la;
        const float ser = -x2 * (1.f + x2 * (0.5f + x2 * (0.16666667f + x2 * (0.041666668f + x2 * (0.0083333338f + x2 * 0.0013888889f)))));
        const float om = x2 > -0.25f ? ser : 1.f - a * a;
        const float mult = __builtin_amdgcn_sqrtf(fmaxf(om, 0.f));
        const float uval = bf2f(sU[tl * 72 + cc]);
        sA[(d * 64 + tl) * 64 + cc] = a;
        sUU[(d * 64 + tl) * 64 + cc] = f2bf(mult * ii * uval);
      }
    }
  }
  __syncthreads();
  float* aggA = (float*)(p.ws + OFF_AGGA);
  float* aggH = (float*)(p.ws + OFF_AGGH);
  if (tid < 128) {
    const int d = tid >> 6, c = tid & 63, gc = n * 64 + c;
    const int tf = d ? 63 : 0, ts = d ? -64 : 64;
    float* pa = sA + (d * 64 + tf) * 64 + c;
    const u16* pu = sUU + (d * 64 + tf) * 64 + c;
    const size_t o = ((size_t)(b * NCH + j) * 2 + d) * 512 + gc;
    float hh = PASS == 1 ? 0.f : aggH[o];
    float A = 1.f;
#pragma unroll
    for (int blk = 0; blk < 2; ++blk) {
      float av[32], uv[32];
#pragma unroll
      for (int k = 0; k < 32; ++k) { av[k] = pa[(blk * 32 + k) * ts]; uv[k] = bf2f(pu[(blk * 32 + k) * ts]); }
#pragma unroll
      for (int k = 0; k < 32; ++k) { A *= av[k]; hh = av[k] * hh + uv[k]; av[k] = hh; }
      if (PASS == 3) {
#pragma unroll
        for (int k = 0; k < 32; ++k) pa[(blk * 32 + k) * ts] = av[k];
      }
    }
    if (PASS == 1) { aggA[o] = A; aggH[o] = hh; }
  }
  if (PASS == 3) {
    __syncthreads();
    u16* mix = (u16*)(p.ws + OFF_H);
#pragma unroll 4
    for (int i = 0; i < 16; ++i) {
      const int idx = tid + 256 * i, t = idx >> 6, c = idx & 63, gc = n * 64 + c;
      const float rsum = sA[t * 64 + c] + sA[(64 + t) * 64 + c];
      const size_t m = (size_t)b * TB + t0 + t;
      const float g = bf2f(zE[m * 2048 + 1440 + gc]);
      mix[m * 1024 + 512 + gc] = f2bf(rsum * silu(g));
    }
  }
  __syncthreads();
}

DI void phase_e2(const Params& p, int li, char* smem) {
  constexpr int N_LRU = NB * NCH * 8, N_Q = (M / 128) * 6, N_KV = (M / 128) * 8, N_KR = M / 16;
  for (int it = lbid(); it < N_LRU + N_Q + N_KV + N_KR; it += gridDim.x) {
    int q = it;
    if (q < N_LRU) { lru_item<1>(p, li, q, smem); continue; }
    q -= N_LRU;
    if (q < N_Q) { qproj_tile(p, li, q / 6, q % 6, smem); continue; }
    q -= N_Q;
    if (q < N_KV) { kvproj_tile(p, li, q >> 3, q & 7, smem); continue; }
    q -= N_KV;
    krope_item(p, q);
  }
}

template <int MODE>
DI void attn_item(const Params& p, int li, int it, char* smem) {
  constexpr int DQK = MODE == 0 ? 96 : 64, KLD = DQK + 8, KS = DQK / 16, VLD = 68;
  constexpr int SK_E = 64 * KLD, SV_E = 64 * VLD;
  u16* sK = (u16*)smem;
  u16* sV = sK + 2 * SK_E;
  float* sBias = (float*)(sV + 2 * SV_E);
  const int tid = ltid(), lane = tid & 63, wid = tid >> 6, r = lane & 31, h = lane >> 5;

  int b, hd, bh, tq, nsteps;
  int qrow = 0, qcol = 0, rsA = 0, rsW = 0;
  const u16* Qp;
  if (MODE == 0) {
    int qb;
    if (it < 2048) { const int ch = it >> 9, w = it & 511; bh = ch * 8 + (w & 7); qb = w >> 3; }
    else { const int jx = it - 2048; bh = jx >> 1; qb = 64 + (jx & 1); }
    b = bh >> 3; hd = bh & 7;
    int tqb;
    if (qb < 64) { tqb = CTX + qb * 128; nsteps = NCH; } else { tqb = (qb - 64) * 128; nsteps = CTX / 64; }
    tq = tqb + wid * 32 + r;
    Qp = (const u16*)(p.ws + OFF_Q) + ((size_t)bh * TB + tq) * 96 + 8 * h;
  } else {
    if (it < 4096) {
      const int ch = it >> 9, w = it & 511;
      bh = ch * 8 + (w & 7); const int rp = w >> 3;
      const int r0 = 2 * rp;
      qrow = r0 + (wid >> 1); qcol = (wid & 1) * 32 + r;
      tq = CTX + qrow * 64 + qcol;
      rsA = min(max(r0 - 4, 0), 120);
      const int rsB = min(max(r0 - 3, 0), 120);
      rsW = (wid >> 1) ? rsB : rsA;
      nsteps = 4 + rsB + 8 - rsA;
    } else {
      const int jx = it - 4096;
      bh = jx >> 1; tq = (jx & 1) * 128 + wid * 32 + r; nsteps = 4;
    }
    b = bh >> 4; hd = bh & 15;
    Qp = (const u16*)(p.ws + OFF_ZO) + ((size_t)b * TB + tq) * 3072 + hd * 64 + 8 * h;
    const float* rpb = p.rpb + ((size_t)li * 16 + hd) * 465;
    for (int e = tid; e < 576; e += 256) { const int k = e - 48; sBias[e] = (k >= 0 && k < 465) ? rpb[k] * LOG2E : 0.f; }
  }
  bf16x8 qf[KS];
#pragma unroll
  for (int s = 0; s < KS; ++s) qf[s] = *(const bf16x8*)(Qp + 16 * s);

  const int lkey = tid >> 3, lc8 = (tid & 7) * 8;
  const int rkey = tid >> 2, rc8 = (tid & 3) * 8;
  uint4 aK0, aK1, aV0, aV1, aR, bK0, bK1, bV0, bV1, bR;
  const u16 *gK, *gV, *gR = nullptr;
  size_t kstride;
  if (MODE == 0) {
    gK = (const u16*)(p.ws + OFF_KN) + ((size_t)bh * TB + lkey) * 64 + lc8; kstride = 64;
    gR = (const u16*)(p.ws + OFF_KR) + ((size_t)b * TB + rkey) * 32 + rc8;
    gV = (const u16*)(p.ws + OFF_VTE) + ((size_t)bh * 64 + lkey) * TB + lc8;
  } else {
    gK = (const u16*)(p.ws + OFF_ZO) + ((size_t)b * TB + lkey) * 3072 + 1024 + hd * 64 + lc8; kstride = 3072;
    gV = (const u16*)(p.ws + OFF_VTO) + ((size_t)bh * 64 + lkey) * TB + lc8;
  }
  auto tile_t0 = [&](int st) -> int { if (MODE == 0) return st * 64; return st < 4 ? st * 64 : CTX + (rsA + st - 4) * 64; };
#define ATT_LOAD(X, st_) do { const int t0_ = tile_t0(st_); \
    X##K0 = *(const uint4*)(gK + (size_t)t0_ * kstride); X##K1 = *(const uint4*)(gK + (size_t)(t0_ + 32) * kstride); \
    if (MODE == 0) X##R = *(const uint4*)(gR + (size_t)t0_ * 32); \
    X##V0 = *(const uint4*)(gV + t0_); X##V1 = *(const uint4*)(gV + (size_t)32 * TB + t0_); } while (0)
#define ATT_STORE(X, sKb_, sVb_) do { \
    *(uint4*)((sKb_) + lkey * KLD + lc8) = X##K0; *(uint4*)((sKb_) + (lkey + 32) * KLD + lc8) = X##K1; \
    if (MODE == 0) *(uint4*)((sKb_) + rkey * KLD + 64 + rc8) = X##R; \
    *(uint2*)((sVb_) + lkey * VLD + lc8) = make_uint2(X##V0.x, X##V0.y); *(uint2*)((sVb_) + lkey * VLD + lc8 + 4) = make_uint2(X##V0.z, X##V0.w); \
    *(uint2*)((sVb_) + (lkey + 32) * VLD + lc8) = make_uint2(X##V1.x, X##V1.y); *(uint2*)((sVb_) + (lkey + 32) * VLD + lc8 + 4) = make_uint2(X##V1.z, X##V1.w); } while (0)
  f32x16 O0, O1;
#pragma unroll
  for (int i = 0; i < 16; ++i) { O0[i] = 0.f; O1[i] = 0.f; }
  float m_run = 0.f, l_run = 0.f;
  f32x16 NEGM;
#pragma unroll
  for (int i = 0; i < 16; ++i) NEGM[i] = 0.f;
  constexpr float THR = 8.f;
  auto compute = [&](const u16* sKb, const u16* sVb, int st) {
    bool active = st < nsteps;
    int krow = 0;
    if (MODE == 1 && st >= 4) { krow = rsA + st - 4; active = active && (krow >= rsW) && (krow < rsW + 8); }
    if (!active) return;
    f32x16 S0 = NEGM, S1 = NEGM;
    bf16x8 kfa[KS], kfb[KS];
#pragma unroll
    for (int s = 0; s < KS; ++s) {
      kfa[s] = *(const bf16x8*)(sKb + r * KLD + 16 * s + 8 * h);
      kfb[s] = *(const bf16x8*)(sKb + (32 + r) * KLD + 16 * s + 8 * h);
    }
#pragma unroll
    for (int s = 0; s < KS; ++s) { S0 = mfma32(kfa[s], qf[s], S0); S1 = mfma32(kfb[s], qf[s], S1); }
    const bool local = MODE == 1 && st >= 4;
    const int qt = qcol >> 5;
    if (local) {
      const int dr = krow - qrow + 7;
      const int cs = min(max(qcol - 8, 0), 48);
      const float* tb = sBias + 48 + dr * 31 - qcol + 15;
      if (qt == 0) {
#pragma unroll
        for (int i = 0; i < 16; ++i) { const int kc = crow(i, h); S0[i] = (unsigned)(kc - cs) < 16u ? S0[i] + tb[kc] : -1e30f; }
#pragma unroll
        for (int i = 0; i < 4; ++i) { const int kc = 32 + crow(i, h); S1[i] = (unsigned)(kc - cs) < 16u ? S1[i] + tb[kc] : -1e30f; }
#pragma unroll
        for (int i = 4; i < 16; ++i) S1[i] = -1e30f;
      } else {
#pragma unroll
        for (int i = 0; i < 12; ++i) S0[i] = -1e30f;
#pragma unroll
        for (int i = 12; i < 16; ++i) { const int kc = crow(i, h); S0[i] = (unsigned)(kc - cs) < 16u ? S0[i] + tb[kc] : -1e30f; }
#pragma unroll
        for (int i = 0; i < 16; ++i) { const int kc = 32 + crow(i, h); S1[i] = (unsigned)(kc - cs) < 16u ? S1[i] + tb[kc] : -1e30f; }
      }
    }
    bool ex = false;
#pragma unroll
    for (int i = 0; i < 16; ++i) ex |= (S0[i] > THR) | (S1[i] > THR);
    if (__any(ex) || st == 0) {
      float pm = fmaxf(S0[0], S1[0]);
#pragma unroll
      for (int i = 1; i < 16; ++i) pm = fmaxf(pm, fmaxf(S0[i], S1[i]));
      pm = swapmax(pm);
      const bool first = st == 0;
      const float delta = first ? pm : fmaxf(pm, 0.f);
      const float al = first ? 1.f : __builtin_amdgcn_exp2f(-delta);
      m_run += delta; l_run *= al;
#pragma unroll
      for (int i = 0; i < 16; ++i) { O0[i] *= al; O1[i] *= al; S0[i] -= delta; S1[i] -= delta; NEGM[i] = -m_run; }
    }
#define VREAD(ds_) const u16* vp = sVb + (32 * (ds_) + r) * VLD + 4 * h; \
      const s16x4 a0 = *(const s16x4*)(vp), a1 = *(const s16x4*)(vp + 8), a2 = *(const s16x4*)(vp + 16), a3 = *(const s16x4*)(vp + 24); \
      const s16x4 a4 = *(const s16x4*)(vp + 32), a5 = *(const s16x4*)(vp + 40), a6 = *(const s16x4*)(vp + 48), a7 = *(const s16x4*)(vp + 56)
#define VCAT(x, y) __builtin_shufflevector(x, y, 0, 1, 2, 3, 4, 5, 6, 7)
    if (local && qt == 0) {
      float ps = 0.f;
#pragma unroll
      for (int i = 0; i < 16; ++i) { S0[i] = __builtin_amdgcn_exp2f(S0[i]); ps += S0[i]; }
#pragma unroll
      for (int i = 0; i < 4; ++i) { S1[i] = __builtin_amdgcn_exp2f(S1[i]); ps += S1[i]; }
      l_run += ps;
      const bf16x8 p00 = pack8(S0[0], S0[1], S0[2], S0[3], S0[4], S0[5], S0[6], S0[7]);
      const bf16x8 p01 = pack8(S0[8], S0[9], S0[10], S0[11], S0[12], S0[13], S0[14], S0[15]);
      const bf16x8 p10 = pack8(S1[0], S1[1], S1[2], S1[3], 0.f, 0.f, 0.f, 0.f);
      { VREAD(0); (void)a6; (void)a7; O0 = mfma32(VCAT(a0, a1), p00, O0); O0 = mfma32(VCAT(a2, a3), p01, O0); O0 = mfma32(VCAT(a4, a5), p10, O0); }
      { VREAD(1); (void)a6; (void)a7; O1 = mfma32(VCAT(a0, a1), p00, O1); O1 = mfma32(VCAT(a2, a3), p01, O1); O1 = mfma32(VCAT(a4, a5), p10, O1); }
      return;
    }
    if (local && qt == 1) {
      float ps = 0.f;
#pragma unroll
      for (int i = 12; i < 16; ++i) { S0[i] = __builtin_amdgcn_exp2f(S0[i]); ps += S0[i]; }
#pragma unroll
      for (int i = 0; i < 16; ++i) { S1[i] = __builtin_amdgcn_exp2f(S1[i]); ps += S1[i]; }
      l_run += ps;
      const bf16x8 p01 = pack8(0.f, 0.f, 0.f, 0.f, S0[12], S0[13], S0[14], S0[15]);
      const bf16x8 p10 = pack8(S1[0], S1[1], S1[2], S1[3], S1[4], S1[5], S1[6], S1[7]);
      const bf16x8 p11 = pack8(S1[8], S1[9], S1[10], S1[11], S1[12], S1[13], S1[14], S1[15]);
      { VREAD(0); (void)a0; (void)a1; O0 = mfma32(VCAT(a2, a3), p01, O0); O0 = mfma32(VCAT(a4, a5), p10, O0); O0 = mfma32(VCAT(a6, a7), p11, O0); }
      { VREAD(1); (void)a0; (void)a1; O1 = mfma32(VCAT(a2, a3), p01, O1); O1 = mfma32(VCAT(a4, a5), p10, O1); O1 = mfma32(VCAT(a6, a7), p11, O1); }
      return;
    }
#undef VREAD
#undef VCAT
    float ps = 0.f;
#pragma unroll
    for (int i = 0; i < 16; ++i) { S0[i] = __builtin_amdgcn_exp2f(S0[i]); S1[i] = __builtin_amdgcn_exp2f(S1[i]); ps += S0[i] + S1[i]; }
    l_run += ps;
    const bf16x8 p00 = pack8(S0[0], S0[1], S0[2], S0[3], S0[4], S0[5], S0[6], S0[7]);
    const bf16x8 p01 = pack8(S0[8], S0[9], S0[10], S0[11], S0[12], S0[13], S0[14], S0[15]);
    const bf16x8 p10 = pack8(S1[0], S1[1], S1[2], S1[3], S1[4], S1[5], S1[6], S1[7]);
    const bf16x8 p11 = pack8(S1[8], S1[9], S1[10], S1[11], S1[12], S1[13], S1[14], S1[15]);
#pragma unroll
    for (int ds = 0; ds < 2; ++ds) {
      const u16* vp = sVb + (32 * ds + r) * VLD + 4 * h;
      const s16x4 a0 = *(const s16x4*)(vp), a1 = *(const s16x4*)(vp + 8), a2 = *(const s16x4*)(vp + 16), a3 = *(const s16x4*)(vp + 24);
      const s16x4 a4 = *(const s16x4*)(vp + 32), a5 = *(const s16x4*)(vp + 40), a6 = *(const s16x4*)(vp + 48), a7 = *(const s16x4*)(vp + 56);
      const bf16x8 v00 = __builtin_shufflevector(a0, a1, 0, 1, 2, 3, 4, 5, 6, 7), v01 = __builtin_shufflevector(a2, a3, 0, 1, 2, 3, 4, 5, 6, 7);
      const bf16x8 v10 = __builtin_shufflevector(a4, a5, 0, 1, 2, 3, 4, 5, 6, 7), v11 = __builtin_shufflevector(a6, a7, 0, 1, 2, 3, 4, 5, 6, 7);
      if (ds == 0) { O0 = mfma32(v00, p00, O0); O0 = mfma32(v01, p01, O0); O0 = mfma32(v10, p10, O0); O0 = mfma32(v11, p11, O0); }
      else         { O1 = mfma32(v00, p00, O1); O1 = mfma32(v01, p01, O1); O1 = mfma32(v10, p10, O1); O1 = mfma32(v11, p11, O1); }
    }
  };
  const int nlast = nsteps - 1, npad = (nsteps + 1) & ~1;
  ATT_LOAD(a, 0);
  ATT_LOAD(b, min(1, nlast));
  for (int st = 0; st < npad; st += 2) {
    ATT_STORE(a, sK, sV);
    ATT_LOAD(a, min(st + 2, nlast));
    __syncthreads();
    compute(sK, sV, st);
    ATT_STORE(b, sK + SK_E, sV + SV_E);
    ATT_LOAD(b, min(st + 3, nlast));
    __syncthreads();
    compute(sK + SK_E, sV + SV_E, st + 1);
  }
#undef ATT_LOAD
#undef ATT_STORE
  {
    const float inv = 1.f / swapsum(l_run);
    const size_t mrow = (size_t)b * TB + tq;
    const u16* gp; u16* op = (u16*)(p.ws + OFF_H) + mrow * 1024 + hd * 64 + 4 * h;
    if (MODE == 0) gp = (const u16*)(p.ws + OFF_ZE) + mrow * 2048 + 416 + hd * 64 + 4 * h;
    else gp = (const u16*)(p.ws + OFF_ZO) + mrow * 3072 + 2048 + hd * 64 + 4 * h;
#pragma unroll
    for (int ds = 0; ds < 2; ++ds)
#pragma unroll
      for (int g = 0; g < 4; ++g) {
        const uint2 gv = *(const uint2*)(gp + 32 * ds + 8 * g);
        const float o0 = (ds ? O1[4 * g] : O0[4 * g]) * inv, o1 = (ds ? O1[4 * g + 1] : O0[4 * g + 1]) * inv;
        const float o2 = (ds ? O1[4 * g + 2] : O0[4 * g + 2]) * inv, o3 = (ds ? O1[4 * g + 3] : O0[4 * g + 3]) * inv;
        uint2 w = {pk2(o0 * silu(bflo(gv.x)), o1 * silu(bfhi(gv.x))), pk2(o2 * silu(bflo(gv.y)), o3 * silu(bfhi(gv.y)))};
        *(uint2*)(op + 32 * ds + 8 * g) = w;
      }
  }
  __syncthreads();
}


DI void mla_item(const Params& p, int li, int it, char* smem) {
  constexpr int KLD = 104, KS = 6, VLD = 68, SK_E = 64 * KLD, SV_E = 64 * VLD;
  u16* sK = (u16*)smem;
  u16* sV = sK + 2 * SK_E;
  const int tid = ltid(), lane = tid & 63, wid = tid >> 6, r = lane & 31, h = lane >> 5;
  int bh, qb;
  if (it < 2048) { const int ch = it >> 9, w = it & 511; bh = ch * 8 + (w & 7); qb = w >> 3; }
  else { const int jx = it - 2048; bh = jx >> 1; qb = 64 + (jx & 1); }
  const int b = bh >> 3, hd = bh & 7;
  int tqb, nsteps;
  if (qb < 64) { tqb = CTX + qb * 128; nsteps = NCH; } else { tqb = (qb - 64) * 128; nsteps = CTX / 64; }
  const int tq = tqb + wid * 32 + r;
  const u16* Qp = (const u16*)(p.ws + OFF_Q) + ((size_t)bh * TB + tq) * 96 + 8 * h;
  bf16x8 qf[KS];
#pragma unroll
  for (int s = 0; s < KS; ++s) qf[s] = *(const bf16x8*)(Qp + 16 * s);
  const int lkey = tid >> 3, lc8 = (tid & 7) * 8;
  const int rkey = tid >> 2, rc8 = (tid & 3) * 8;
  const u16* gK = (const u16*)(p.ws + OFF_KN) + ((size_t)bh * TB + lkey) * 64 + lc8;
  const u16* gR = (const u16*)(p.ws + OFF_KR) + ((size_t)b * TB + rkey) * 32 + rc8;
  const u16* gV = (const u16*)(p.ws + OFF_VTE) + ((size_t)bh * 64 + lkey) * TB + lc8;
  const int nlast = nsteps - 1;
  uint4 aK0, aK1, aR, aV0, aV1, bK0, bK1, bR, bV0, bV1;
#define LD_K(X, tile_) do { const int t0_ = min((tile_), nlast) * 64; \
    X##K0 = *(const uint4*)(gK + (size_t)t0_ * 64); X##K1 = *(const uint4*)(gK + (size_t)(t0_ + 32) * 64); X##R = *(const uint4*)(gR + (size_t)t0_ * 32); } while (0)
#define LD_V(X, tile_) do { const int t0_ = min((tile_), nlast) * 64; \
    X##V0 = *(const uint4*)(gV + t0_); X##V1 = *(const uint4*)(gV + (size_t)32 * TB + t0_); } while (0)
#define ST_K(X, kb_) do { u16* d_ = sK + (kb_) * SK_E; \
    *(uint4*)(d_ + lkey * KLD + lc8) = X##K0; *(uint4*)(d_ + (lkey + 32) * KLD + lc8) = X##K1; *(uint4*)(d_ + rkey * KLD + 64 + rc8) = X##R; } while (0)
#define ST_V(X, vb_) do { u16* d_ = sV + (vb_) * SV_E; \
    *(uint2*)(d_ + lkey * VLD + lc8) = make_uint2(X##V0.x, X##V0.y); *(uint2*)(d_ + lkey * VLD + lc8 + 4) = make_uint2(X##V0.z, X##V0.w); \
    *(uint2*)(d_ + (lkey + 32) * VLD + lc8) = make_uint2(X##V1.x, X##V1.y); *(uint2*)(d_ + (lkey + 32) * VLD + lc8 + 4) = make_uint2(X##V1.z, X##V1.w); } while (0)
  f32x16 O0, O1, NEGM;
#pragma unroll
  for (int i = 0; i < 16; ++i) { O0[i] = 0.f; O1[i] = 0.f; NEGM[i] = 0.f; }
  float m_run = 0.f, l_run = 0.f;
  constexpr float THR = 8.f;
  auto qk = [&](const u16* kb, f32x16& A0, f32x16& A1) {
    A0 = NEGM; A1 = NEGM;
#pragma unroll
    for (int s = 0; s < KS; ++s) {
      const bf16x8 k0 = *(const bf16x8*)(kb + r * KLD + 16 * s + 8 * h);
      const bf16x8 k1 = *(const bf16x8*)(kb + (32 + r) * KLD + 16 * s + 8 * h);
      A0 = mfma32(k0, qf[s], A0); A1 = mfma32(k1, qf[s], A1);
    }
  };
  auto check = [&](f32x16& A0, f32x16& A1, const bool first) {
    bool ex = false;
#pragma unroll
    for (int i = 0; i < 16; ++i) ex |= (A0[i] > THR) | (A1[i] > THR);
    if (__any(ex) || first) {
      float pm = fmaxf(A0[0], A1[0]);
#pragma unroll
      for (int i = 1; i < 16; ++i) pm = fmaxf(pm, fmaxf(A0[i], A1[i]));
      pm = swapmax(pm);
      const float delta = first ? pm : fmaxf(pm, 0.f);
      const float al = first ? 1.f : __builtin_amdgcn_exp2f(-delta);
      m_run += delta; l_run *= al;
#pragma unroll
      for (int i = 0; i < 16; ++i) { O0[i] *= al; O1[i] *= al; A0[i] -= delta; A1[i] -= delta; NEGM[i] = -m_run; }
    }
  };
  auto smpv = [&](f32x16& A0, f32x16& A1, const u16* vb) {
    float ps = 0.f;
#pragma unroll
    for (int i = 0; i < 16; ++i) { A0[i] = __builtin_amdgcn_exp2f(A0[i]); A1[i] = __builtin_amdgcn_exp2f(A1[i]); ps += A0[i] + A1[i]; }
    l_run += ps;
    const bf16x8 p00 = pack8(A0[0], A0[1], A0[2], A0[3], A0[4], A0[5], A0[6], A0[7]);
    const bf16x8 p01 = pack8(A0[8], A0[9], A0[10], A0[11], A0[12], A0[13], A0[14], A0[15]);
    const bf16x8 p10 = pack8(A1[0], A1[1], A1[2], A1[3], A1[4], A1[5], A1[6], A1[7]);
    const bf16x8 p11 = pack8(A1[8], A1[9], A1[10], A1[11], A1[12], A1[13], A1[14], A1[15]);
#pragma unroll
    for (int ds = 0; ds < 2; ++ds) {
      const u16* vp = vb + (32 * ds + r) * VLD + 4 * h;
      const s16x4 a0 = *(const s16x4*)(vp), a1 = *(const s16x4*)(vp + 8), a2 = *(const s16x4*)(vp + 16), a3 = *(const s16x4*)(vp + 24);
      const s16x4 a4 = *(const s16x4*)(vp + 32), a5 = *(const s16x4*)(vp + 40), a6 = *(const s16x4*)(vp + 48), a7 = *(const s16x4*)(vp + 56);
      const bf16x8 v00 = __builtin_shufflevector(a0, a1, 0, 1, 2, 3, 4, 5, 6, 7), v01 = __builtin_shufflevector(a2, a3, 0, 1, 2, 3, 4, 5, 6, 7);
      const bf16x8 v10 = __builtin_shufflevector(a4, a5, 0, 1, 2, 3, 4, 5, 6, 7), v11 = __builtin_shufflevector(a6, a7, 0, 1, 2, 3, 4, 5, 6, 7);
      if (ds == 0) { O0 = mfma32(v00, p00, O0); O0 = mfma32(v01, p01, O0); O0 = mfma32(v10, p10, O0); O0 = mfma32(v11, p11, O0); }
      else         { O1 = mfma32(v00, p00, O1); O1 = mfma32(v01, p01, O1); O1 = mfma32(v10, p10, O1); O1 = mfma32(v11, p11, O1); }
    }
  };
  LD_K(a, 0); LD_V(a, 0); LD_K(b, 1);
  ST_K(a, 0); ST_V(a, 0); ST_K(b, 1);
  LD_K(a, 2); LD_V(a, 1); LD_K(b, 3); LD_V(b, 2);
  __syncthreads();
  f32x16 Sc0, Sc1, Sn0, Sn1;
  qk(sK, Sc0, Sc1);
  check(Sc0, Sc1, true);
  for (int j = 0; j < nsteps; j += 2) {
    ST_K(a, 0); ST_V(a, 1);
    LD_K(a, j + 4); LD_V(a, j + 3);
    qk(sK + SK_E, Sn0, Sn1);
    smpv(Sc0, Sc1, sV);
    check(Sn0, Sn1, false);
    __syncthreads();
    ST_K(b, 1); ST_V(b, 0);
    LD_K(b, j + 5); LD_V(b, j + 4);
    qk(sK, Sc0, Sc1);
    smpv(Sn0, Sn1, sV + SV_E);
    check(Sc0, Sc1, false);
    __syncthreads();
  }
#undef LD_K
#undef LD_V
#undef ST_K
#undef ST_V
  {
    const float inv = 1.f / swapsum(l_run);
    const size_t mrow = (size_t)b * TB + tq;
    u16* op = (u16*)(p.ws + OFF_H) + mrow * 1024 + hd * 64 + 4 * h;
    const u16* gp = (const u16*)(p.ws + OFF_ZE) + mrow * 2048 + 416 + hd * 64 + 4 * h;
#pragma unroll
    for (int ds = 0; ds < 2; ++ds)
#pragma unroll
      for (int g = 0; g < 4; ++g) {
        const uint2 gv = *(const uint2*)(gp + 32 * ds + 8 * g);
        const float o0 = (ds ? O1[4 * g] : O0[4 * g]) * inv, o1 = (ds ? O1[4 * g + 1] : O0[4 * g + 1]) * inv;
        const float o2 = (ds ? O1[4 * g + 2] : O0[4 * g + 2]) * inv, o3 = (ds ? O1[4 * g + 3] : O0[4 * g + 3]) * inv;
        uint2 w = {pk2(o0 * silu(bflo(gv.x)), o1 * silu(bfhi(gv.x))), pk2(o2 * silu(bflo(gv.y)), o3 * silu(bfhi(gv.y)))};
        *(uint2*)(op + 32 * ds + 8 * g) = w;
      }
  }
  __syncthreads();
}

DI void phase_e3(const Params& p, int li, char* smem) {
  constexpr int N_MLA = 2048 + 64, N_LRU = NB * NCH * 8;
  const bool lru_first = lbid() >= (int)(gridDim.x >> 1);
  for (int stage = 0; stage < 2; ++stage) {
    if ((stage == 0) == lru_first) {
      for (int it = lbid(); it < N_LRU; it += gridDim.x) lru_item<3>(p, li, it, smem);
    } else {
      for (int it = lbid(); it < N_MLA; it += gridDim.x) mla_item(p, li, it, smem);
    }
  }
}
DI void phase_na(const Params& p, int li, int nitems, char* smem) {
  for (int it = lbid(); it < nitems; it += gridDim.x) attn_item<1>(p, li, it, smem);
}


#define XB_TMO      128
#define XB_XCNT(j)  (256  + 64 * (j))
#define XB_XSUB(j)  (1280 + 64 * (j))
#define XB_XGEN(j)  (2304 + 64 * (j))
#define XB_TOP      3328
#define XB_TOPGEN   3392
#define XCD_BAR_WORDS 3456
#define XB_SPIN_CAP (1u << 22)
#define LAS __attribute__((address_space(3)))
DI unsigned xb_ld(unsigned* p)              { return __hip_atomic_load(p, __ATOMIC_RELAXED, __HIP_MEMORY_SCOPE_AGENT); }
DI unsigned xb_add(unsigned* p, unsigned v) { return __hip_atomic_fetch_add(p, v, __ATOMIC_RELAXED, __HIP_MEMORY_SCOPE_AGENT); }
DI unsigned xb_xcc_id() { return (unsigned)__builtin_amdgcn_s_getreg((3 << 11) | 20) & 0xFu; }
#define XB_SPIN(cond, bar) do { unsigned _sp = 0; while (cond) { __builtin_amdgcn_s_sleep(1); \
    if ((++_sp & 255u) == 0u) { if (xb_ld(&(bar)[XB_TMO])) break; if (_sp > XB_SPIN_CAP) { atomicAdd(&(bar)[XB_TMO], 1u); break; } } } } while (0)
struct XcdBarrier { unsigned* bar; unsigned x; volatile LAS unsigned* st; };
DI XcdBarrier xcd_barrier_post(unsigned* bar, volatile LAS unsigned* st) {
  XcdBarrier b; b.bar = bar; b.x = xb_xcc_id(); b.st = st;
  if (threadIdx.x == 0) (void)xb_add(&bar[XB_XCNT(b.x)], 1u);
  return b;
}
DI void xcd_barrier_complete(unsigned* bar, unsigned x, unsigned& nloc, unsigned& nx) {
  const unsigned G = gridDim.x * gridDim.y * gridDim.z;
  unsigned sum, cnt, mine, sp = 0u;
  for (;;) {
    sum = 0u; cnt = 0u; mine = 0u;
#pragma unroll
    for (unsigned j = 0; j < 16; ++j) { const unsigned c = xb_ld(&bar[XB_XCNT(j)]); sum += c; cnt += (c > 0u) ? 1u : 0u; mine = (j == x) ? c : mine; }
    if (sum == G) break;
    __builtin_amdgcn_s_sleep(1);
    if ((++sp & 255u) == 0u) { if (xb_ld(&bar[XB_TMO])) break; if (sp > XB_SPIN_CAP) { atomicAdd(&bar[XB_TMO], 1u); break; } }
  }
  nloc = mine > 0u ? mine : 1u; nx = cnt > 0u ? cnt : 1u;
}
DI void xcd_barrier(const XcdBarrier& b) {
  asm volatile("s_waitcnt vmcnt(0)" ::: "memory");
  __syncthreads();
  if (threadIdx.x == 0) {
    unsigned* bar = b.bar;
    __builtin_amdgcn_s_waitcnt(0);
    unsigned nloc = b.st[0], nx = b.st[1];
    if (nloc == 0u) { xcd_barrier_complete(bar, b.x, nloc, nx); b.st[0] = nloc; b.st[1] = nx; }
    const unsigned old = xb_add(&bar[XB_XSUB(b.x)], 1u);
    const unsigned gen = old / nloc;
    if (old + 1u == (gen + 1u) * nloc) {
      __builtin_amdgcn_fence(__ATOMIC_RELEASE, "agent");
      asm volatile("s_waitcnt vmcnt(0)" ::: "memory");
      const unsigned og = xb_add(&bar[XB_TOP], 1u);
      const unsigned tg = og / nx;
      if (og + 1u == (tg + 1u) * nx) xb_add(&bar[XB_TOPGEN], 1u);
      else XB_SPIN(xb_ld(&bar[XB_TOPGEN]) == tg, bar);
      __builtin_amdgcn_fence(__ATOMIC_ACQUIRE, "agent");
      xb_add(&bar[XB_XGEN(b.x)], 1u);
      asm volatile("s_waitcnt vmcnt(0)" ::: "memory");
    } else {
      XB_SPIN(xb_ld(&bar[XB_XGEN(b.x)]) == gen, bar);
      __builtin_amdgcn_fence(__ATOMIC_ACQUIRE, "agent");
      asm volatile("s_waitcnt vmcnt(0)" ::: "memory");
    }
  }
  __syncthreads();
}

DI void phase_lru_carry(const Params& p) {
  float* aggA = (float*)(p.ws + OFF_AGGA);
  float* aggH = (float*)(p.ws + OFF_AGGH);
  const int g = lbid() * 256 + ltid();
  if (g >= NB * 2 * 512) return;
  const int b = g >> 10, d = (g >> 9) & 1, c = g & 511;
  const size_t ob = (size_t)b * NCH * 1024 + d * 512 + c;
  float hh = 0.f;
  for (int s0 = 0; s0 < NCH; s0 += 12) {
    float a[12], hv[12]; size_t o[12];
#pragma unroll
    for (int u = 0; u < 12; ++u) {
      const int s = s0 + u;
      const int j = d == 0 ? s : (s < 4 ? 3 - s : NCH + 3 - s);
      o[u] = ob + (size_t)j * 1024; a[u] = aggA[o[u]]; hv[u] = aggH[o[u]];
    }
#pragma unroll
    for (int u = 0; u < 12; ++u) { aggH[o[u]] = hh; hh = a[u] * hh + hv[u]; }
  }
}

#ifndef DUP
#define DUP 0
#endif
#define REP(k) for (int rep_ = 0; rep_ < ((DUP) == (k) ? 2 : 1); ++rep_)
__global__ void __launch_bounds__(256, 2) mega(Params p) {
  __shared__ __attribute__((aligned(16))) char smem[LRU_SMEM];
  __shared__ uint4 xb_words;
  cg::grid_group grid = cg::this_grid();
  if (threadIdx.x == 0) xb_words = make_uint4(0u, 0u, 0u, 0u);
  __syncthreads();
  const XcdBarrier xbar = xcd_barrier_post((unsigned*)(p.ws + OFF_BAR), (volatile LAS unsigned*)&xb_words);
  REP(9) phase_prep(p, smem);
  grid.sync();
  for (int L = 0; L < NLAYERS_RUN; ++L) {
    const int li = L >> 1;
    REP(1) phase_norm(p, L);
    do { xcd_barrier(xbar); if (DUP == 10) xcd_barrier(xbar); } while (0);
    if ((L & 1) == 0) {
      REP(2) phase_win_even(p, li, smem);
      do { xcd_barrier(xbar); if (DUP == 10) xcd_barrier(xbar); } while (0);
      REP(3) phase_e2(p, li, smem);
      do { xcd_barrier(xbar); if (DUP == 10) xcd_barrier(xbar); } while (0);
      phase_lru_carry(p);
      do { xcd_barrier(xbar); if (DUP == 10) xcd_barrier(xbar); } while (0);
      REP(4) phase_e3(p, li, smem);
      do { xcd_barrier(xbar); if (DUP == 10) xcd_barrier(xbar); } while (0);
    } else {
      REP(6) phase_win_odd(p, li, smem);
      do { xcd_barrier(xbar); if (DUP == 10) xcd_barrier(xbar); } while (0);
      REP(7) phase_na(p, li, L < 3 ? 4096 + 128 : 4096, smem);
      do { xcd_barrier(xbar); if (DUP == 10) xcd_barrier(xbar); } while (0);
    }
    if (DUP == 8) { phase_out(p, L, smem, true); }
    phase_out(p, L, smem);
    do { xcd_barrier(xbar); if (DUP == 10) xcd_barrier(xbar); } while (0);
  }
  phase_final_norm(p);
}

extern "C" void kernel_launch(void* const* d_in, const int* in_sizes, int n_in, void* d_out, int out_size, void* d_ws, size_t ws_size,
                              hipStream_t stream) {
  static int grid_blocks = 0;
  if (!grid_blocks) {
    int dev = 0, cus = 0, per_cu = 0;
    hipGetDevice(&dev);
    hipDeviceGetAttribute(&cus, hipDeviceAttributeMultiprocessorCount, dev);
    hipOccupancyMaxActiveBlocksPerMultiprocessor(&per_cu, mega, 256, 0);
    per_cu = 2;
    grid_blocks = cus * per_cu;
  }
  if (ws_size < WS_NEED) { fprintf(stderr, "kernel_launch: workspace too small: %zu < %zu\n", ws_size, WS_NEED); return; }
  if (hipMemsetAsync((char*)d_ws + OFF_BAR, 0, 16384, stream) != hipSuccess) { fprintf(stderr, "kernel_launch: memset failed\n"); return; }
  Params p{};
  const float** f = (const float**)&p;
  for (int i = 0; i < 24; ++i) f[i] = (const float*)d_in[i];
  p.out = (float*)d_out;
  p.ws = (char*)d_ws;
  void* args[] = {&p};
  hipError_t e = hipLaunchCooperativeKernel((void*)mega, dim3(grid_blocks), dim3(256), args, 0, stream);
  if (e != hipSuccess) fprintf(stderr, "cooperative launch failed: %s (grid %d)\n", hipGetErrorString(e), grid_blocks);
}
```

```cpp
#include <hip/hip_runtime.h>
#include <hip/hip_cooperative_groups.h>
#include <cstdio>
namespace cg = cooperative_groups;

#define DI __device__ __forceinline__
typedef unsigned short u16;
using bf16x8 = __attribute__((ext_vector_type(8))) short;
using s16x4  = __attribute__((ext_vector_type(4))) short;
using f32x16 = __attribute__((ext_vector_type(16))) float;
typedef __bf16 bf2_t __attribute__((ext_vector_type(2)));
typedef float fl2_t __attribute__((ext_vector_type(2)));

#ifndef NLAYERS_RUN
#define NLAYERS_RUN 4
#endif

constexpr int D = 1024, NB = 4, SEQ = 8192, CTX = 256, TB = SEQ + CTX, M = NB * TB;
constexpr int NCH = TB / 64;
constexpr float LOG2E = 1.4426950408889634f;
constexpr float MLA_QS = 0.10206207261596575f * LOG2E;
constexpr float RMS_EPS = 1e-6f;

constexpr size_t SZ_WINE = (size_t)2048 * 1024 * 2, SZ_WUQ = (size_t)768 * 256 * 2, SZ_WUKV = (size_t)1024 * 128 * 2;
constexpr size_t SZ_WOUT = (size_t)1024 * 1024 * 2, SZ_WINO = (size_t)4096 * 1024 * 2, SZ_WLRU = (size_t)32 * 4096 * 2;
constexpr size_t OFF_WINE = 0;
constexpr size_t OFF_WUQ = OFF_WINE + 2 * SZ_WINE;
constexpr size_t OFF_WUKV = OFF_WUQ + 2 * SZ_WUQ;
constexpr size_t OFF_WOUTE = OFF_WUKV + 2 * SZ_WUKV;
constexpr size_t OFF_WINO = OFF_WOUTE + 2 * SZ_WOUT;
constexpr size_t OFF_WOUTO = OFF_WINO + 2 * SZ_WINO;
constexpr size_t OFF_WA = OFF_WOUTO + 2 * SZ_WOUT;
constexpr size_t OFF_WX = OFF_WA + SZ_WLRU;
constexpr size_t OFF_MOD = OFF_WX + SZ_WLRU;
constexpr size_t SZ_MOD = (size_t)4 * 5 * 3072 * 4;
constexpr size_t OFF_CX = OFF_MOD + SZ_MOD;
constexpr size_t SZ_CX = (size_t)NB * CTX * D * 4;
constexpr size_t OFF_H = OFF_CX + SZ_CX;
constexpr size_t SZ_H = (size_t)M * D * 2;
constexpr size_t OFF_Z = OFF_H + SZ_H;
constexpr size_t OFF_ZE = OFF_Z;
constexpr size_t SZ_ZE = (size_t)M * 2048 * 2;
constexpr size_t OFF_Q = OFF_ZE + SZ_ZE;
constexpr size_t SZ_Q = (size_t)NB * 8 * TB * 96 * 2;
constexpr size_t OFF_KN = OFF_Q + SZ_Q;
constexpr size_t SZ_KN = (size_t)NB * 8 * TB * 64 * 2;
constexpr size_t OFF_KR = OFF_KN + SZ_KN;
constexpr size_t SZ_KR = (size_t)NB * TB * 32 * 2;
constexpr size_t OFF_VTE = OFF_KR + SZ_KR;
constexpr size_t SZ_VTE = (size_t)NB * 8 * 64 * TB * 2;
constexpr size_t OFF_AGGA = OFF_VTE + SZ_VTE;
constexpr size_t SZ_AGG = (size_t)NB * NCH * 2 * 512 * 4;
constexpr size_t OFF_AGGH = OFF_AGGA + SZ_AGG;
constexpr size_t END_EVEN = OFF_AGGH + SZ_AGG;
constexpr size_t OFF_ZO = OFF_Z;
constexpr size_t SZ_ZO = (size_t)M * 3072 * 2;
constexpr size_t OFF_VTO = OFF_ZO + SZ_ZO;
constexpr size_t SZ_VTO = (size_t)NB * 16 * 64 * TB * 2;
constexpr size_t END_ODD = OFF_VTO + SZ_VTO;
constexpr size_t OFF_BAR = END_EVEN > END_ODD ? END_EVEN : END_ODD;
constexpr size_t OFF_XB = OFF_BAR + 16384;
constexpr size_t WS_NEED = OFF_XB + (size_t)M * D * 2;

struct Params {
  const float *x, *c, *ctx, *c_ctx, *ada_w, *ada_b, *norm_g, *ev_w_in, *q_norm, *w_uq, *kv_norm, *w_ukv;
  const float *conv_w, *conv_b, *wa, *ba, *wx, *bx, *lam, *ev_w_out, *od_w_in, *rpb, *od_w_out, *fin_g;
  float* out;
  char* ws;
};

DI int ltid() { int t = threadIdx.x & 255; asm volatile("" : "+v"(t)); return t; }
DI int lhalf() { return __builtin_amdgcn_readfirstlane((int)(threadIdx.x >> 8)); }
DI int lbid() { const int b = blockIdx.x; int t = (b & 7) + 8 * (2 * (b >> 3) + lhalf()); asm volatile("" : "+s"(t)); return t; }
#define VGRID ((int)(gridDim.x * 2))
DI int pbid() { int t = blockIdx.x; asm volatile("" : "+s"(t)); return t; }
DI unsigned pk2(float a, float b) { fl2_t f = {a, b}; bf2_t r = __builtin_convertvector(f, bf2_t); return __builtin_bit_cast(unsigned, r); }
DI u16 f2bf(float a) { return (u16)(pk2(a, a) & 0xffffu); }
DI float bf2f(u16 v) { return __uint_as_float(((unsigned)v) << 16); }
DI float bflo(unsigned w) { return __uint_as_float(w << 16); }
DI float bfhi(unsigned w) { return __uint_as_float(w & 0xffff0000u); }
DI f32x16 mfma32(bf16x8 a, bf16x8 b, f32x16 c) { return __builtin_amdgcn_mfma_f32_32x32x16_bf16(a, b, c, 0, 0, 0); }
DI int crow(int i, int h) { return (i & 3) + 8 * (i >> 2) + 4 * h; }
DI float silu(float g) { return g * __builtin_amdgcn_rcpf(1.f + __expf(-g)); }
DI float sigmoidf(float g) { return __builtin_amdgcn_rcpf(1.f + __expf(-g)); }
DI float swapmax(float v) { auto rr = __builtin_amdgcn_permlane32_swap(__float_as_uint(v), __float_as_uint(v), false, false);
  return fmaxf(__uint_as_float(rr[0]), __uint_as_float(rr[1])); }
DI float swapsum(float v) { auto rr = __builtin_amdgcn_permlane32_swap(__float_as_uint(v), __float_as_uint(v), false, false);
  return __uint_as_float(rr[0]) + __uint_as_float(rr[1]); }
DI float wave_sum(float v) {
#pragma unroll
  for (int o = 32; o >= 1; o >>= 1) v += __shfl_xor(v, o);
  return v; }
DI bf16x8 pack8(float a0, float a1, float a2, float a3, float a4, float a5, float a6, float a7) {
  uint4 w = {pk2(a0, a1), pk2(a2, a3), pk2(a4, a5), pk2(a6, a7)}; return __builtin_bit_cast(bf16x8, w); }

constexpr int GLD = 72;
template <bool SUMSQ>
DI void gemm_core(const u16* __restrict__ P, int ldp, const u16* __restrict__ Q, int ldq, int K,
                  u16* sP, u16* sQ, f32x16 (&acc)[2][2], float (&ss)[2]) {
  const int tid = ltid(), lane = tid & 63, wid = tid >> 6, r = lane & 31, h = lane >> 5, wm = wid >> 1, wn = wid & 1;
  const int lr = tid >> 3, lc = (tid & 7) * 8;
  uint4 rp0, rp1, rp2, rp3, rq0, rq1, rq2, rq3;
#pragma unroll
  for (int a = 0; a < 2; ++a)
#pragma unroll
    for (int b = 0; b < 2; ++b)
#pragma unroll
      for (int i = 0; i < 16; ++i) acc[a][b][i] = 0.f;
  ss[0] = 0.f; ss[1] = 0.f;
  const u16* Pg = P + (size_t)lr * ldp + lc;
  const u16* Qg = Q + (size_t)lr * ldq + lc;
#define GLOADPQ(KO) do { \
    rp0 = *(const uint4*)(Pg + (KO)); rp1 = *(const uint4*)(Pg + (size_t)32 * ldp + (KO)); \
    rp2 = *(const uint4*)(Pg + (size_t)64 * ldp + (KO)); rp3 = *(const uint4*)(Pg + (size_t)96 * ldp + (KO)); \
    rq0 = *(const uint4*)(Qg + (KO)); rq1 = *(const uint4*)(Qg + (size_t)32 * ldq + (KO)); \
    rq2 = *(const uint4*)(Qg + (size_t)64 * ldq + (KO)); rq3 = *(const uint4*)(Qg + (size_t)96 * ldq + (KO)); } while (0)
  GLOADPQ(0);
  if (lhalf()) __syncthreads();
  for (int k0 = 0; k0 < K; k0 += 64) {
    __syncthreads();
    *(uint4*)(sP + (lr) * GLD + lc) = rp0; *(uint4*)(sP + (lr + 32) * GLD + lc) = rp1;
    *(uint4*)(sP + (lr + 64) * GLD + lc) = rp2; *(uint4*)(sP + (lr + 96) * GLD + lc) = rp3;
    *(uint4*)(sQ + (lr) * GLD + lc) = rq0; *(uint4*)(sQ + (lr + 32) * GLD + lc) = rq1;
    *(uint4*)(sQ + (lr + 64) * GLD + lc) = rq2; *(uint4*)(sQ + (lr + 96) * GLD + lc) = rq3;
    __syncthreads();
    if (k0 + 64 < K) GLOADPQ(k0 + 64);
#pragma unroll
    for (int s = 0; s < 4; ++s) {
      const bf16x8 a0 = *(const bf16x8*)(sP + (wm * 64 + r) * GLD + s * 16 + h * 8);
      const bf16x8 a1 = *(const bf16x8*)(sP + (wm * 64 + 32 + r) * GLD + s * 16 + h * 8);
      const bf16x8 b0 = *(const bf16x8*)(sQ + (wn * 64 + r) * GLD + s * 16 + h * 8);
      const bf16x8 b1 = *(const bf16x8*)(sQ + (wn * 64 + 32 + r) * GLD + s * 16 + h * 8);
      if (SUMSQ) {
#pragma unroll
        for (int j = 0; j < 8; ++j) { float f0 = bf2f((u16)b0[j]), f1 = bf2f((u16)b1[j]); ss[0] += f0 * f0; ss[1] += f1 * f1; }
      }
      acc[0][0] = mfma32(a0, b0, acc[0][0]); acc[0][1] = mfma32(a0, b1, acc[0][1]);
      acc[1][0] = mfma32(a1, b0, acc[1][0]); acc[1][1] = mfma32(a1, b1, acc[1][1]);
    }
  }
  if (!lhalf()) __syncthreads();
}

DI void epi_store_rows(const f32x16 (&acc)[2][2], u16* C, int ldc, int m0, int n0, int nvalid) {
  const int tid = ltid(), lane = tid & 63, wid = tid >> 6, r = lane & 31, h = lane >> 5, wm = wid >> 1, wn = wid & 1;
#pragma unroll
  for (int ni = 0; ni < 2; ++ni) {
    const int nb = n0 + wn * 64 + ni * 32;
    if (nb >= nvalid) continue;
#pragma unroll
    for (int mi = 0; mi < 2; ++mi)
#pragma unroll
      for (int i = 0; i < 16; ++i) {
        const int m = m0 + wm * 64 + mi * 32 + crow(i, h);
        C[(size_t)m * ldc + nb + r] = f2bf(acc[mi][ni][i]);
      }
  }
}
DI void epi_store_vt(const f32x16 (&acc)[2][2], u16* Vt, int nheads, int m0, int nn0) {
  const int tid = ltid(), lane = tid & 63, wid = tid >> 6, r = lane & 31, h = lane >> 5, wm = wid >> 1, wn = wid & 1;
  const int b = m0 / TB, tb0 = m0 % TB;
#pragma unroll
  for (int ni = 0; ni < 2; ++ni) {
    const int nn = nn0 + wn * 64 + ni * 32 + r, hd = nn >> 6, d = nn & 63;
    u16* base = Vt + ((size_t)(b * nheads + hd) * 64 + d) * TB + tb0 + wm * 64 + 4 * h;
#pragma unroll
    for (int mi = 0; mi < 2; ++mi)
#pragma unroll
      for (int g = 0; g < 4; ++g) {
        uint2 w = {pk2(acc[mi][ni][4 * g], acc[mi][ni][4 * g + 1]), pk2(acc[mi][ni][4 * g + 2], acc[mi][ni][4 * g + 3])};
        *(uint2*)(base + mi * 32 + 8 * g) = w;
      }
  }
}

DI void prep_tile(const float* __restrict__ src, int lds_, int nsrc, int k0, int n0, u16* __restrict__ dst, int K, int dn0,
                  const float* __restrict__ rowscale, float cscale, float* sT) {
  const int tid = ltid();
#pragma unroll
  for (int i = 0; i < 4; ++i) {
    const int idx = tid + 256 * i, kk = idx >> 4, n4 = (idx & 15) * 4;
    const bool ok = n0 + n4 < nsrc;
    float4 v = *(const float4*)(src + (size_t)(k0 + kk) * lds_ + (ok ? n0 + n4 : 0));
    if (!ok) v = make_float4(0.f, 0.f, 0.f, 0.f);
    const float sc = cscale * (rowscale ? rowscale[k0 + kk] : 1.f);
    sT[(n4 + 0) * 65 + kk] = v.x * sc; sT[(n4 + 1) * 65 + kk] = v.y * sc; sT[(n4 + 2) * 65 + kk] = v.z * sc; sT[(n4 + 3) * 65 + kk] = v.w * sc;
  }
  __syncthreads();
#pragma unroll
  for (int i = 0; i < 2; ++i) {
    const int idx = tid + 256 * i, n = idx >> 3, c = (idx & 7) * 8;
    const float* s = sT + n * 65 + c;
    uint4 w = {pk2(s[0], s[1]), pk2(s[2], s[3]), pk2(s[4], s[5]), pk2(s[6], s[7])};
    *(uint4*)(dst + (size_t)(dn0 + n) * K + k0 + c) = w;
  }
  __syncthreads();
}

DI void phase_prep(const Params& p, char* smem) {
  const int tid = ltid(), lane = tid & 63, wid = tid >> 6;
  constexpr int NADA = 192, PER_I = 512 + 48 + 32 + 256 + 1024 + 256, NTOT = NADA + 2 * PER_I + 64;
  for (int it = lbid(); it < NTOT; it += VGRID) {
    if (it < NADA) {
      const int layer = it / 48, j = (it % 48) * 64 + lane;
      float* sCond = (float*)smem;
      float* sRed = sCond + 5 * 1024;
      for (int e = tid; e < 5 * 1024; e += 256) { const float v = e < 4096 ? p.c[e] : p.c_ctx[e - 4096]; sCond[e] = silu(v); }
      __syncthreads();
      float a0 = 0.f, a1 = 0.f, a2 = 0.f, a3 = 0.f, a4 = 0.f;
      const float* w = p.ada_w + ((size_t)layer * 1024 + wid * 256) * 3072 + j;
      const float* sc = sCond + wid * 256;
#pragma unroll 8
      for (int k = 0; k < 256; ++k) {
        const float wv = w[(size_t)k * 3072];
        a0 += sc[k] * wv; a1 += sc[1024 + k] * wv; a2 += sc[2048 + k] * wv; a3 += sc[3072 + k] * wv; a4 += sc[4096 + k] * wv;
      }
      sRed[(wid * 5 + 0) * 64 + lane] = a0; sRed[(wid * 5 + 1) * 64 + lane] = a1; sRed[(wid * 5 + 2) * 64 + lane] = a2;
      sRed[(wid * 5 + 3) * 64 + lane] = a3; sRed[(wid * 5 + 4) * 64 + lane] = a4;
      __syncthreads();
      if (tid < 64) {
        float* mod = (float*)(p.ws + OFF_MOD);
        const float bias = p.ada_b[layer * 3072 + j];
#pragma unroll
        for (int rw = 0; rw < 5; ++rw) {
          const float s = sRed[(0 * 5 + rw) * 64 + lane] + sRed[(1 * 5 + rw) * 64 + lane] + sRed[(2 * 5 + rw) * 64 + lane] + sRed[(3 * 5 + rw) * 64 + lane];
          mod[((size_t)layer * 5 + rw) * 3072 + j] = s + bias;
        }
      }
      __syncthreads();
      continue;
    }
    int q = it - NADA;
    float* sT = (float*)smem;
    if (q < 2 * PER_I) {
      const int i = q / PER_I; q -= i * PER_I;
      if (q < 512) {
        const int kt = q & 15, nt = q >> 4;
        prep_tile(p.ev_w_in + (size_t)i * 1024 * 1952, 1952, 1952, kt * 64, nt * 64, (u16*)(p.ws + OFF_WINE + i * SZ_WINE), 1024, nt * 64, nullptr, 1.f, sT);
      } else if (q < 560) {
        q -= 512; const int kt = q & 3, nt = q >> 2;
        prep_tile(p.w_uq + (size_t)i * 256 * 768, 768, 768, kt * 64, nt * 64, (u16*)(p.ws + OFF_WUQ + i * SZ_WUQ), 256, nt * 64, p.q_norm + i * 256, 1.f, sT);
      } else if (q < 592) {
        q -= 560; const int kt = q & 1, nt = q >> 1;
        prep_tile(p.w_ukv + (size_t)i * 128 * 1024, 1024, 1024, kt * 64, nt * 64, (u16*)(p.ws + OFF_WUKV + i * SZ_WUKV), 128, nt * 64, p.kv_norm + i * 128, 1.f, sT);
      } else if (q < 848) {
        q -= 592; const int kt = q & 15, nt = q >> 4;
        prep_tile(p.ev_w_out + (size_t)i * 1024 * 1024, 1024, 1024, kt * 64, nt * 64, (u16*)(p.ws + OFF_WOUTE + i * SZ_WOUT), 1024, nt * 64, nullptr, 1.f, sT);
      } else if (q < 1872) {
        q -= 848; const int kt = q & 15, nt = q >> 4;
        const int n0 = nt * 64, reg = n0 >> 10;
        const int dn0 = (reg == 2 ? 3072 : reg == 3 ? 2048 : reg * 1024) + (n0 & 1023);
        prep_tile(p.od_w_in + (size_t)i * 1024 * 4096, 4096, 4096, kt * 64, n0, (u16*)(p.ws + OFF_WINO + i * SZ_WINO), 1024, dn0, nullptr, reg == 0 ? 0.125f * LOG2E : 1.f, sT);
      } else {
        q -= 1872; const int kt = q & 15, nt = q >> 4;
        prep_tile(p.od_w_out + (size_t)i * 1024 * 1024, 1024, 1024, kt * 64, nt * 64, (u16*)(p.ws + OFF_WOUTO + i * SZ_WOUT), 1024, nt * 64, nullptr, 1.f, sT);
      }
    } else {
      q -= 2 * PER_I;
      if (q < 32) prep_tile(p.wa + (size_t)q * 4096, 64, 64, 0, 0, (u16*)(p.ws + OFF_WA) + (size_t)q * 4096, 64, 0, nullptr, 1.f, sT);
      else { q -= 32; prep_tile(p.wx + (size_t)q * 4096, 64, 64, 0, 0, (u16*)(p.ws + OFF_WX) + (size_t)q * 4096, 64, 0, nullptr, 1.f, sT); }
    }
  }
}

DI const float* resid_in(const Params& p, int L, int b, int t) {
  if (t < CTX) return (L == 0 ? p.ctx : (const float*)(p.ws + OFF_CX)) + ((size_t)b * CTX + t) * D;
  return (L == 0 ? p.x : (const float*)p.out) + ((size_t)b * SEQ + (t - CTX)) * D;
}
DI float* resid_out(const Params& p, int b, int t) {
  if (t < CTX) return (float*)(p.ws + OFF_CX) + ((size_t)b * CTX + t) * D;
  return p.out + ((size_t)b * SEQ + (t - CTX)) * D;
}

DI void phase_norm(const Params& p, int L) {
  const int tid = ltid(), lane = tid & 63, wid = tid >> 6;
  const float* mod = (const float*)(p.ws + OFF_MOD);
  u16* hbuf = (u16*)(p.ws + OFF_H);
  for (int it = lbid(); it < M / 4; it += VGRID) {
    const int m = it * 4 + wid, b = m / TB, t = m % TB, mrow = t < CTX ? 4 : b;
    float4 v[4]; float ssq = 0.f;
    if (L == 0) {
      const float4* src = (const float4*)resid_in(p, 0, b, t);
#pragma unroll
      for (int j = 0; j < 4; ++j) v[j] = src[lane + 64 * j];
    } else {
      const uint2* src = (const uint2*)((const u16*)(p.ws + OFF_XB) + (size_t)m * 1024);
#pragma unroll
      for (int j = 0; j < 4; ++j) { const uint2 w = src[lane + 64 * j]; v[j] = make_float4(bflo(w.x), bfhi(w.x), bflo(w.y), bfhi(w.y)); }
    }
#pragma unroll
    for (int j = 0; j < 4; ++j) ssq += v[j].x * v[j].x + v[j].y * v[j].y + v[j].z * v[j].z + v[j].w * v[j].w;
    ssq = wave_sum(ssq);
    const float rs = rsqrtf(ssq * (1.f / 1024.f) + RMS_EPS);
    const float4* g4 = (const float4*)(p.norm_g + L * 1024);
    const float4* sh4 = (const float4*)(mod + ((size_t)L * 5 + mrow) * 3072);
    const float4* sc4 = sh4 + 256;
#pragma unroll
    for (int j = 0; j < 4; ++j) {
      const int k4 = lane + 64 * j;
      const float4 g = g4[k4], sh = sh4[k4], sc = sc4[k4];
      const float y0 = v[j].x * rs * g.x * (1.f + sc.x) + sh.x, y1 = v[j].y * rs * g.y * (1.f + sc.y) + sh.y;
      const float y2 = v[j].z * rs * g.z * (1.f + sc.z) + sh.z, y3 = v[j].w * rs * g.w * (1.f + sc.w) + sh.w;
      uint2 w = {pk2(y0, y1), pk2(y2, y3)};
      *(uint2*)(hbuf + (size_t)m * 1024 + k4 * 4) = w;
    }
  }
}

DI void phase_final_norm(const Params& p) {
  const int tid = ltid(), lane = tid & 63, wid = tid >> 6;
  for (int it = lbid(); it < NB * SEQ / 4; it += VGRID) {
    const int m = it * 4 + wid;
    float4* row = (float4*)(p.out + (size_t)m * 1024);
    float4 v[4]; float ssq = 0.f;
#pragma unroll
    for (int j = 0; j < 4; ++j) { v[j] = row[lane + 64 * j]; ssq += v[j].x * v[j].x + v[j].y * v[j].y + v[j].z * v[j].z + v[j].w * v[j].w; }
    ssq = wave_sum(ssq);
    const float rs = rsqrtf(ssq * (1.f / 1024.f) + RMS_EPS);
    const float4* g4 = (const float4*)p.fin_g;
#pragma unroll
    for (int j = 0; j < 4; ++j) {
      const float4 g = g4[lane + 64 * j];
      row[lane + 64 * j] = make_float4(v[j].x * rs * g.x, v[j].y * rs * g.y, v[j].z * rs * g.z, v[j].w * rs * g.w);
    }
  }
}

DI void phase_win_even(const Params& p, int li, char* smem) {
  u16* sP = (u16*)smem; u16* sQ = sP + 128 * GLD;
  const u16* A = (const u16*)(p.ws + OFF_H);
  const u16* W = (const u16*)(p.ws + OFF_WINE + li * SZ_WINE);
  u16* Z = (u16*)(p.ws + OFF_ZE);
  for (int it = lbid(); it < (M / 128) * 16; it += VGRID) {
    const int mt = it >> 4, nt = it & 15;
    f32x16 acc[2][2]; float ss[2];
    gemm_core<false>(A + (size_t)mt * 128 * 1024, 1024, W + (size_t)nt * 128 * 1024, 1024, 1024, sP, sQ, acc, ss);
    epi_store_rows(acc, Z, 2048, mt * 128, nt * 128, 1952);
  }
}
DI void phase_win_odd(const Params& p, int li, char* smem) {
  u16* sP = (u16*)smem; u16* sQ = sP + 128 * GLD;
  const u16* A = (const u16*)(p.ws + OFF_H);
  const u16* W = (const u16*)(p.ws + OFF_WINO + li * SZ_WINO);
  u16* Z = (u16*)(p.ws + OFF_ZO);
  u16* Vt = (u16*)(p.ws + OFF_VTO);
  for (int it = lbid(); it < (M / 128) * 32; it += VGRID) {
    const int mt = it >> 5, nt = it & 31;
    f32x16 acc[2][2]; float ss[2];
    gemm_core<false>(A + (size_t)mt * 128 * 1024, 1024, W + (size_t)nt * 128 * 1024, 1024, 1024, sP, sQ, acc, ss);
    if (nt < 24) epi_store_rows(acc, Z, 3072, mt * 128, nt * 128, 3072);
    else epi_store_vt(acc, Vt, 16, mt * 128, nt * 128 - 3072);
  }
}

DI void phase_out(const Params& p, int L, char* smem, bool dry = false) {
  u16* sP = (u16*)smem; u16* sQ = sP + 128 * GLD;
  const int li = L >> 1;
  const u16* A = (const u16*)(p.ws + OFF_H);
  const u16* W = (const u16*)(p.ws + ((L & 1) ? OFF_WOUTO : OFF_WOUTE) + li * SZ_WOUT);
  const float* mod = (const float*)(p.ws + OFF_MOD);
  const int tid = ltid(), lane = tid & 63, wid = tid >> 6, r = lane & 31, h = lane >> 5, wm = wid >> 1, wn = wid & 1;
  for (int it = lbid(); it < (M / 128) * 8; it += VGRID) {
    const int mt = it >> 3, nt = it & 7;
    const int m0 = mt * 128, b = m0 / TB, tb0 = m0 % TB;
    const bool isctx = tb0 < CTX;
    if (isctx && L == 3) continue;
    f32x16 acc[2][2]; float ss[2];
    gemm_core<false>(A + (size_t)m0 * 1024, 1024, W + (size_t)nt * 128 * 1024, 1024, 1024, sP, sQ, acc, ss);
    const float* rin32 = resid_in(p, 0, b, tb0);
    u16* xb = (u16*)(p.ws + (dry ? OFF_Z : OFF_XB)) + (size_t)m0 * 1024;
    const u16* xin = (const u16*)(p.ws + OFF_XB) + (size_t)m0 * 1024;
    float* rout32 = p.out + ((size_t)b * SEQ + (tb0 - CTX)) * D;
    const float* gate = mod + ((size_t)L * 5 + (isctx ? 4 : b)) * 3072 + 2048;
#pragma unroll
    for (int ni = 0; ni < 2; ++ni) {
      const int n = nt * 128 + wn * 64 + ni * 32 + r;
      const float gt = gate[n];
#pragma unroll
      for (int mi = 0; mi < 2; ++mi)
#pragma unroll
        for (int i = 0; i < 16; ++i) {
          const size_t o = (size_t)(wm * 64 + mi * 32 + crow(i, h)) * 1024 + n;
          const float xv = L == 0 ? rin32[o] : bf2f(xin[o]);
          const float y = xv + gt * acc[mi][ni][i];
          if (L == 3 && !dry) rout32[o] = y; else xb[o] = f2bf(y);
        }
    }
  }
}

DI void qproj_tile(const Params& p, int li, int mt, int nt, char* smem) {
  u16* sP = (u16*)smem; u16* sQ = sP + 128 * GLD;
  const int tid = ltid(), lane = tid & 63, wid = tid >> 6, r = lane & 31, h = lane >> 5, wm = wid >> 1, wn = wid & 1;
  const u16* W = (const u16*)(p.ws + OFF_WUQ + li * SZ_WUQ);
  const u16* Z = (const u16*)(p.ws + OFF_ZE);
  u16* Qb = (u16*)(p.ws + OFF_Q);
  f32x16 acc[2][2]; float ss[2];
  gemm_core<true>(W + (size_t)nt * 128 * 256, 256, Z + (size_t)mt * 128 * 2048, 2048, 256, sP, sQ, acc, ss);
#pragma unroll
  for (int ni = 0; ni < 2; ++ni) {
    const float rs = rsqrtf(swapsum(ss[ni]) * (1.f / 256.f) + RMS_EPS);
    const int m = mt * 128 + wn * 64 + ni * 32 + r, b = m / TB, t = m % TB;
    const int pos = t - CTX;
    const float prow = (float)(pos >> 6), pcol = (float)(pos & 63);
#pragma unroll
    for (int mi = 0; mi < 2; ++mi) {
      const int gt = (nt * 128 + wm * 64 + mi * 32) >> 5, hd = gt / 3, part = gt % 3;
      float v[16];
#pragma unroll
      for (int i = 0; i < 16; ++i) v[i] = acc[mi][ni][i] * rs;
      if (part == 2 && t >= CTX) {
#pragma unroll
        for (int i = 0; i < 4; ++i) {
          const float inv = exp2f(-(float)(4 * h + i) * 1.6609640474436813f);
          float ar = prow * inv, ac = pcol * inv;
          const float cr = __cosf(ar), sr = __sinf(ar), cc = __cosf(ac), sc = __sinf(ac);
          const float x1 = v[i], x2 = v[i + 4], y1 = v[8 + i], y2 = v[12 + i];
          v[i] = x1 * cr - x2 * sr; v[i + 4] = x2 * cr + x1 * sr;
          v[8 + i] = y1 * cc - y2 * sc; v[12 + i] = y2 * cc + y1 * sc;
        }
      }
      u16* dst = Qb + ((size_t)(b * 8 + hd) * TB + t) * 96 + part * 32 + 4 * h;
#pragma unroll
      for (int g = 0; g < 4; ++g) {
        uint2 w = {pk2(v[4 * g] * MLA_QS, v[4 * g + 1] * MLA_QS), pk2(v[4 * g + 2] * MLA_QS, v[4 * g + 3] * MLA_QS)};
        *(uint2*)(dst + 8 * g) = w;
      }
    }
  }
}
DI void kvproj_tile(const Params& p, int li, int mt, int nt, char* smem) {
  u16* sP = (u16*)smem; u16* sQ = sP + 128 * GLD;
  const int tid = ltid(), lane = tid & 63, wid = tid >> 6, r = lane & 31, h = lane >> 5, wm = wid >> 1, wn = wid & 1;
  const u16* W = (const u16*)(p.ws + OFF_WUKV + li * SZ_WUKV);
  const u16* Z = (const u16*)(p.ws + OFF_ZE);
  u16* Kn = (u16*)(p.ws + OFF_KN);
  u16* Vt = (u16*)(p.ws + OFF_VTE);
  f32x16 acc[2][2]; float ss[2];
  gemm_core<true>(W + (size_t)nt * 128 * 128, 128, Z + (size_t)mt * 128 * 2048 + 256, 2048, 128, sP, sQ, acc, ss);
#pragma unroll
  for (int ni = 0; ni < 2; ++ni) {
    const float rs = rsqrtf(swapsum(ss[ni]) * (1.f / 128.f) + RMS_EPS);
    const int m = mt * 128 + wn * 64 + ni * 32 + r, b = m / TB, t = m % TB;
#pragma unroll
    for (int mi = 0; mi < 2; ++mi) {
      const int gt = (nt * 128 + wm * 64 + mi * 32) >> 5, hd = gt >> 2, part = gt & 3;
      if (part < 2) {
        u16* dst = Kn + ((size_t)(b * 8 + hd) * TB + t) * 64 + part * 32 + 4 * h;
#pragma unroll
        for (int g = 0; g < 4; ++g) {
          uint2 w = {pk2(acc[mi][ni][4 * g] * rs, acc[mi][ni][4 * g + 1] * rs), pk2(acc[mi][ni][4 * g + 2] * rs, acc[mi][ni][4 * g + 3] * rs)};
          *(uint2*)(dst + 8 * g) = w;
        }
      } else {
        u16* dst = Vt + ((size_t)(b * 8 + hd) * 64 + (part - 2) * 32) * TB + t;
#pragma unroll
        for (int i = 0; i < 16; ++i) dst[(size_t)crow(i, h) * TB] = f2bf(acc[mi][ni][i] * rs);
      }
    }
  }
}
DI void krope_item(const Params& p, int it) {
  const int tid = ltid();
  const int m = it * 16 + (tid >> 4), f = tid & 15, blk = f >> 3, fi = f & 7;
  const int t = m % TB;
  const u16* src = (const u16*)(p.ws + OFF_ZE) + (size_t)m * 2048 + 384 + 16 * blk + fi;
  u16* dst = (u16*)(p.ws + OFF_KR) + (size_t)m * 32 + 16 * blk + fi;
  float x1 = bf2f(src[0]), x2 = bf2f(src[8]);
  if (t >= CTX) {
    const int pos = t - CTX;
    const float ang = (float)(blk ? (pos & 63) : (pos >> 6)) * exp2f(-(float)fi * 1.6609640474436813f);
    const float c = __cosf(ang), s = __sinf(ang);
    const float y1 = x1 * c - x2 * s, y2 = x2 * c + x1 * s;
    x1 = y1; x2 = y2;
  }
  dst[0] = f2bf(x1); dst[8] = f2bf(x2);
}

constexpr int LRU_SU = 0, LRU_SA = 64 * 72 * 2, LRU_SUU = LRU_SA + 2 * 64 * 64 * 4, LRU_SMEM = LRU_SUU + 2 * 64 * 64 * 2;
template <int PASS>
DI void lru_item(const Params& p, int li, int it, char* smem) {
  const int tid = ltid(), lane = tid & 63, wid = tid >> 6, r = lane & 31, h = lane >> 5;
  const int n = it & 7, j = (it >> 3) % NCH, b = it / (8 * NCH);
  const int t0 = j * 64, seg_lo = j < 4 ? 0 : CTX, seg_hi = j < 4 ? CTX : TB;
  u16* sU = (u16*)(smem + LRU_SU);
  float* sA = (float*)(smem + LRU_SA);
  u16* sUU = (u16*)(smem + LRU_SUU);
  const u16* zE = (const u16*)(p.ws + OFF_ZE);
  const int mi = wid >> 1, ni = wid & 1;
  const int cc = ni * 32 + r, gcw = n * 64 + cc;
  const int cconv = tid & 63, tg = tid >> 6, gcc = n * 64 + cconv;
  const u16* zcol = zE + (size_t)b * TB * 2048 + 928 + gcc;
  const int tb = t0 + tg * 16;
  float xv[19];
#pragma unroll
  for (int q = 0; q < 19; ++q) {
    const int t = tb - 2 + q; const bool ok = (t >= seg_lo) && (t < seg_hi);
    const float v = bf2f(zcol[(size_t)(ok ? t : seg_lo) * 2048]);
    xv[q] = ok ? v : 0.f;
  }
  const float* cw = p.conv_w + (size_t)li * 4 * 512 + gcc;
  const float w0 = cw[0], w1 = cw[512], w2 = cw[1024], w3 = cw[1536], cb = p.conv_b[li * 512 + gcc];
  const u16* WA = (const u16*)(p.ws + OFF_WA) + ((size_t)(li * 2) * 8 + n) * 4096 + (ni * 32 + r) * 64 + 8 * h;
  const u16* WX = (const u16*)(p.ws + OFF_WX) + ((size_t)(li * 2) * 8 + n) * 4096 + (ni * 32 + r) * 64 + 8 * h;
  bf16x8 wfa[2][4], wfx[2][4];
#pragma unroll
  for (int d = 0; d < 2; ++d)
#pragma unroll
    for (int s = 0; s < 4; ++s) { wfa[d][s] = *(const bf16x8*)(WA + (size_t)d * 8 * 4096 + 16 * s); wfx[d][s] = *(const bf16x8*)(WX + (size_t)d * 8 * 4096 + 16 * s); }
  float pba[2], pbx[2], plam[2];
#pragma unroll
  for (int d = 0; d < 2; ++d) { const int pi = (li * 2 + d) * 512 + gcw; pba[d] = p.ba[pi]; pbx[d] = p.bx[pi]; plam[d] = p.lam[pi]; }
  float* aggA = (float*)(p.ws + OFF_AGGA);
  float* aggH = (float*)(p.ws + OFF_AGGH);
  const int dsc = (tid >> 6) & 1, csc = tid & 63;
  const size_t osc = ((size_t)(b * NCH + j) * 2 + dsc) * 512 + n * 64 + csc;
  float carry = 0.f; u16 gq[16];
  if (PASS == 3) {
    carry = aggH[osc];
#pragma unroll
    for (int i = 0; i < 16; ++i) { const int idx = tid + 256 * i, t = idx >> 6, c = idx & 63; gq[i] = zE[((size_t)b * TB + t0 + t) * 2048 + 1440 + n * 64 + c]; }
  }
  {
#pragma unroll
    for (int tt = 0; tt < 16; ++tt) {
      const float u = w0 * xv[tt] + w1 * xv[tt + 1] + w2 * xv[tt + 2] + w3 * xv[tt + 3] + cb;
      sU[(tg * 16 + tt) * 72 + cconv] = f2bf(u);
    }
  }
  __syncthreads();
  {
    f32x16 acc[2][2];
#pragma unroll
    for (int d = 0; d < 2; ++d)
#pragma unroll
      for (int q = 0; q < 2; ++q)
#pragma unroll
        for (int i = 0; i < 16; ++i) acc[d][q][i] = 0.f;
#pragma unroll
    for (int s = 0; s < 4; ++s) {
      const bf16x8 af = *(const bf16x8*)(sU + (mi * 32 + r) * 72 + 16 * s + 8 * h);
#pragma unroll
      for (int d = 0; d < 2; ++d) { acc[d][0] = mfma32(af, wfa[d][s], acc[d][0]); acc[d][1] = mfma32(af, wfx[d][s], acc[d][1]); }
    }
#pragma unroll
    for (int d = 0; d < 2; ++d) {
      const float ba = pba[d], bx = pbx[d], lam = plam[d];
      const float sp = log1pf(__expf(-lam));
#pragma unroll
      for (int i = 0; i < 16; ++i) {
        const int tl = mi * 32 + crow(i, h);
        const float rr = sigmoidf(acc[d][0][i] + ba), ii = sigmoidf(acc[d][1][i] + bx);
        const float la = -8.f * rr * sp;
        const float a = __expf(la);
        const float x2 = 2.f * la;
        const float ser = -x2 * (1.f + x2 * (0.5f + x2 * (0.16666667f + x2 * (0.041666668f + x2 * (0.0083333338f + x2 * 0.0013888889f)))));
        const float om = x2 > -0.25f ? ser : 1.f - a * a;
        const float mult = __builtin_amdgcn_sqrtf(fmaxf(om, 0.f));
        const float uval = bf2f(sU[tl * 72 + cc]);
        sA[(d * 64 + tl) * 64 + cc] = a;
        sUU[(d * 64 + tl) * 64 + cc] = f2bf(mult * ii * uval);
      }
    }
  }
  __syncthreads();
  if (tid < 128) {
    const int d = tid >> 6, c = tid & 63, gc = n * 64 + c;
    const int tf = d ? 63 : 0, ts = d ? -64 : 64;
    float* pa = sA + (d * 64 + tf) * 64 + c;
    const u16* pu = sUU + (d * 64 + tf) * 64 + c;
    const size_t o = ((size_t)(b * NCH + j) * 2 + d) * 512 + gc;
    float hh = PASS == 1 ? 0.f : carry;
    float A = 1.f;
#pragma unroll
    for (int blk = 0; blk < 2; ++blk) {
      float av[32], uv[32];
#pragma unroll
      for (int k = 0; k < 32; ++k) { av[k] = pa[(blk * 32 + k) * ts]; uv[k] = bf2f(pu[(blk * 32 + k) * ts]); }
#pragma unroll
      for (int k = 0; k < 32; ++k) { A *= av[k]; hh = av[k] * hh + uv[k]; av[k] = hh; }
      if (PASS == 3) {
#pragma unroll
        for (int k = 0; k < 32; ++k) pa[(blk * 32 + k) * ts] = av[k];
      }
    }
    if (PASS == 1) { aggA[o] = A; aggH[o] = hh; }
  }
  if (PASS == 3) {
    __syncthreads();
    u16* mix = (u16*)(p.ws + OFF_H);
#pragma unroll
    for (int i = 0; i < 16; ++i) {
      const int idx = tid + 256 * i, t = idx >> 6, c = idx & 63, gc = n * 64 + c;
      const float rsum = sA[t * 64 + c] + sA[(64 + t) * 64 + c];
      const size_t m = (size_t)b * TB + t0 + t;
      const float g = bf2f(gq[i]);
      mix[m * 1024 + 512 + gc] = f2bf(rsum * silu(g));
    }
  }
  __syncthreads();
}

DI void phase_e2(const Params& p, int li, char* smem) {
  constexpr int N_LRU = NB * NCH * 8, N_Q = (M / 128) * 6, N_KV = (M / 128) * 8, N_KR = M / 16;
  for (int it = lbid(); it < N_LRU + N_Q + N_KV + N_KR; it += VGRID) {
    int q = it;
    if (q < N_LRU) { lru_item<1>(p, li, q, smem); continue; }
    q -= N_LRU;
    if (q < N_Q) { qproj_tile(p, li, q / 6, q % 6, smem); continue; }
    q -= N_Q;
    if (q < N_KV) { kvproj_tile(p, li, q >> 3, q & 7, smem); continue; }
    q -= N_KV;
    krope_item(p, q);
  }
}

template <int MODE>
DI void attn_item(const Params& p, int li, int it, char* smem) {
  constexpr int DQK = MODE == 0 ? 96 : 64, KLD = DQK + 8, KS = DQK / 16, VLD = 68;
  constexpr int SK_E = 64 * KLD, SV_E = 64 * VLD;
  u16* sK = (u16*)smem;
  u16* sV = sK + 2 * SK_E;
  float* sBias = (float*)(sV + 2 * SV_E);
  const int tid = ltid(), lane = tid & 63, wid = tid >> 6, r = lane & 31, h = lane >> 5;

  int b, hd, bh, tq, nsteps;
  int qrow = 0, qcol = 0, rsA = 0, rsW = 0;
  const u16* Qp;
  if (MODE == 0) {
    int qb;
    if (it < 2048) { const int ch = it >> 9, w = it & 511; bh = ch * 8 + (w & 7); qb = w >> 3; }
    else { const int jx = it - 2048; bh = jx >> 1; qb = 64 + (jx & 1); }
    b = bh >> 3; hd = bh & 7;
    int tqb;
    if (qb < 64) { tqb = CTX + qb * 128; nsteps = NCH; } else { tqb = (qb - 64) * 128; nsteps = CTX / 64; }
    tq = tqb + wid * 32 + r;
    Qp = (const u16*)(p.ws + OFF_Q) + ((size_t)bh * TB + tq) * 96 + 8 * h;
  } else {
    if (it < 4096) {
      const int ch = it >> 9, w = it & 511;
      bh = ch * 8 + (w & 7); const int rp = w >> 3;
      const int r0 = 2 * rp;
      qrow = r0 + (wid >> 1); qcol = (wid & 1) * 32 + r;
      tq = CTX + qrow * 64 + qcol;
      rsA = min(max(r0 - 4, 0), 120);
      const int rsB = min(max(r0 - 3, 0), 120);
      rsW = (wid >> 1) ? rsB : rsA;
      nsteps = 4 + rsB + 8 - rsA;
    } else {
      const int jx = it - 4096;
      bh = jx >> 1; tq = (jx & 1) * 128 + wid * 32 + r; nsteps = 4;
    }
    b = bh >> 4; hd = bh & 15;
    Qp = (const u16*)(p.ws + OFF_ZO) + ((size_t)b * TB + tq) * 3072 + hd * 64 + 8 * h;
    const float* rpb = p.rpb + ((size_t)li * 16 + hd) * 465;
    for (int e = tid; e < 576; e += 256) { const int k = e - 48; sBias[e] = (k >= 0 && k < 465) ? rpb[k] * LOG2E : 0.f; }
  }
  bf16x8 qf[KS];
#pragma unroll
  for (int s = 0; s < KS; ++s) qf[s] = *(const bf16x8*)(Qp + 16 * s);

  const int lkey = tid >> 3, lc8 = (tid & 7) * 8;
  const int rkey = tid >> 2, rc8 = (tid & 3) * 8;
  uint4 aK0, aK1, aV0, aV1, aR, bK0, bK1, bV0, bV1, bR;
  const u16 *gK, *gV, *gR = nullptr;
  size_t kstride;
  if (MODE == 0) {
    gK = (const u16*)(p.ws + OFF_KN) + ((size_t)bh * TB + lkey) * 64 + lc8; kstride = 64;
    gR = (const u16*)(p.ws + OFF_KR) + ((size_t)b * TB + rkey) * 32 + rc8;
    gV = (const u16*)(p.ws + OFF_VTE) + ((size_t)bh * 64 + lkey) * TB + lc8;
  } else {
    gK = (const u16*)(p.ws + OFF_ZO) + ((size_t)b * TB + lkey) * 3072 + 1024 + hd * 64 + lc8; kstride = 3072;
    gV = (const u16*)(p.ws + OFF_VTO) + ((size_t)bh * 64 + lkey) * TB + lc8;
  }
  auto tile_t0 = [&](int st) -> int { if (MODE == 0) return st * 64; return st < 4 ? st * 64 : CTX + (rsA + st - 4) * 64; };
#define ATT_LOAD(X, st_) do { const int t0_ = tile_t0(st_); \
    X##K0 = *(const uint4*)(gK + (size_t)t0_ * kstride); X##K1 = *(const uint4*)(gK + (size_t)(t0_ + 32) * kstride); \
    if (MODE == 0) X##R = *(const uint4*)(gR + (size_t)t0_ * 32); \
    X##V0 = *(const uint4*)(gV + t0_); X##V1 = *(const uint4*)(gV + (size_t)32 * TB + t0_); } while (0)
#define ATT_STORE(X, sKb_, sVb_) do { \
    *(uint4*)((sKb_) + lkey * KLD + lc8) = X##K0; *(uint4*)((sKb_) + (lkey + 32) * KLD + lc8) = X##K1; \
    if (MODE == 0) *(uint4*)((sKb_) + rkey * KLD + 64 + rc8) = X##R; \
    *(uint2*)((sVb_) + lkey * VLD + lc8) = make_uint2(X##V0.x, X##V0.y); *(uint2*)((sVb_) + lkey * VLD + lc8 + 4) = make_uint2(X##V0.z, X##V0.w); \
    *(uint2*)((sVb_) + (lkey + 32) * VLD + lc8) = make_uint2(X##V1.x, X##V1.y); *(uint2*)((sVb_) + (lkey + 32) * VLD + lc8 + 4) = make_uint2(X##V1.z, X##V1.w); } while (0)
  f32x16 O0, O1;
#pragma unroll
  for (int i = 0; i < 16; ++i) { O0[i] = 0.f; O1[i] = 0.f; }
  float m_run = 0.f, l_run = 0.f;
  f32x16 NEGM;
#pragma unroll
  for (int i = 0; i < 16; ++i) NEGM[i] = 0.f;
  constexpr float THR = 8.f;
  auto compute = [&](const u16* sKb, const u16* sVb, int st) {
    bool active = st < nsteps;
    int krow = 0;
    if (MODE == 1 && st >= 4) { krow = rsA + st - 4; active = active && (krow >= rsW) && (krow < rsW + 8); }
    if (!active) return;
    f32x16 S0 = NEGM, S1 = NEGM;
    bf16x8 kfa[KS], kfb[KS];
#pragma unroll
    for (int s = 0; s < KS; ++s) {
      kfa[s] = *(const bf16x8*)(sKb + r * KLD + 16 * s + 8 * h);
      kfb[s] = *(const bf16x8*)(sKb + (32 + r) * KLD + 16 * s + 8 * h);
    }
#pragma unroll
    for (int s = 0; s < KS; ++s) { S0 = mfma32(kfa[s], qf[s], S0); S1 = mfma32(kfb[s], qf[s], S1); }
    const bool local = MODE == 1 && st >= 4;
    const int qt = qcol >> 5;
    if (local) {
      const int dr = krow - qrow + 7;
      const int cs = min(max(qcol - 8, 0), 48);
      const float* tb = sBias + 48 + dr * 31 - qcol + 15;
      if (qt == 0) {
#pragma unroll
        for (int i = 0; i < 16; ++i) { const int kc = crow(i, h); S0[i] = (unsigned)(kc - cs) < 16u ? S0[i] + tb[kc] : -1e30f; }
#pragma unroll
        for (int i = 0; i < 4; ++i) { const int kc = 32 + crow(i, h); S1[i] = (unsigned)(kc - cs) < 16u ? S1[i] + tb[kc] : -1e30f; }
#pragma unroll
        for (int i = 4; i < 16; ++i) S1[i] = -1e30f;
      } else {
#pragma unroll
        for (int i = 0; i < 12; ++i) S0[i] = -1e30f;
#pragma unroll
        for (int i = 12; i < 16; ++i) { const int kc = crow(i, h); S0[i] = (unsigned)(kc - cs) < 16u ? S0[i] + tb[kc] : -1e30f; }
#pragma unroll
        for (int i = 0; i < 16; ++i) { const int kc = 32 + crow(i, h); S1[i] = (unsigned)(kc - cs) < 16u ? S1[i] + tb[kc] : -1e30f; }
      }
    }
    bool ex = false;
#pragma unroll
    for (int i = 0; i < 16; ++i) ex |= (S0[i] > THR) | (S1[i] > THR);
    if (__any(ex) || st == 0) {
      float pm = fmaxf(S0[0], S1[0]);
#pragma unroll
      for (int i = 1; i < 16; ++i) pm = fmaxf(pm, fmaxf(S0[i], S1[i]));
      pm = swapmax(pm);
      const bool first = st == 0;
      const float delta = first ? pm : fmaxf(pm, 0.f);
      const float al = first ? 1.f : __builtin_amdgcn_exp2f(-delta);
      m_run += delta; l_run *= al;
#pragma unroll
      for (int i = 0; i < 16; ++i) { O0[i] *= al; O1[i] *= al; S0[i] -= delta; S1[i] -= delta; NEGM[i] = -m_run; }
    }
#define VREAD(ds_) const u16* vp = sVb + (32 * (ds_) + r) * VLD + 4 * h; \
      const s16x4 a0 = *(const s16x4*)(vp), a1 = *(const s16x4*)(vp + 8), a2 = *(const s16x4*)(vp + 16), a3 = *(const s16x4*)(vp + 24); \
      const s16x4 a4 = *(const s16x4*)(vp + 32), a5 = *(const s16x4*)(vp + 40), a6 = *(const s16x4*)(vp + 48), a7 = *(const s16x4*)(vp + 56)
#define VCAT(x, y) __builtin_shufflevector(x, y, 0, 1, 2, 3, 4, 5, 6, 7)
    if (local && qt == 0) {
      float ps = 0.f;
#pragma unroll
      for (int i = 0; i < 16; ++i) { S0[i] = __builtin_amdgcn_exp2f(S0[i]); ps += S0[i]; }
#pragma unroll
      for (int i = 0; i < 4; ++i) { S1[i] = __builtin_amdgcn_exp2f(S1[i]); ps += S1[i]; }
      l_run += ps;
      const bf16x8 p00 = pack8(S0[0], S0[1], S0[2], S0[3], S0[4], S0[5], S0[6], S0[7]);
      const bf16x8 p01 = pack8(S0[8], S0[9], S0[10], S0[11], S0[12], S0[13], S0[14], S0[15]);
      const bf16x8 p10 = pack8(S1[0], S1[1], S1[2], S1[3], 0.f, 0.f, 0.f, 0.f);
      { VREAD(0); (void)a6; (void)a7; O0 = mfma32(VCAT(a0, a1), p00, O0); O0 = mfma32(VCAT(a2, a3), p01, O0); O0 = mfma32(VCAT(a4, a5), p10, O0); }
      { VREAD(1); (void)a6; (void)a7; O1 = mfma32(VCAT(a0, a1), p00, O1); O1 = mfma32(VCAT(a2, a3), p01, O1); O1 = mfma32(VCAT(a4, a5), p10, O1); }
      return;
    }
    if (local && qt == 1) {
      float ps = 0.f;
#pragma unroll
      for (int i = 12; i < 16; ++i) { S0[i] = __builtin_amdgcn_exp2f(S0[i]); ps += S0[i]; }
#pragma unroll
      for (int i = 0; i < 16; ++i) { S1[i] = __builtin_amdgcn_exp2f(S1[i]); ps += S1[i]; }
      l_run += ps;
      const bf16x8 p01 = pack8(0.f, 0.f, 0.f, 0.f, S0[12], S0[13], S0[14], S0[15]);
      const bf16x8 p10 = pack8(S1[0], S1[1], S1[2], S1[3], S1[4], S1[5], S1[6], S1[7]);
      const bf16x8 p11 = pack8(S1[8], S1[9], S1[10], S1[11], S1[12], S1[13], S1[14], S1[15]);
      { VREAD(0); (void)a0; (void)a1; O0 = mfma32(VCAT(a2, a3), p01, O0); O0 = mfma32(VCAT(a4, a5), p10, O0); O0 = mfma32(VCAT(a6, a7), p11, O0); }
      { VREAD(1); (void)a0; (void)a1; O1 = mfma32(VCAT(a2, a3), p01, O1); O1 = mfma32(VCAT(a4, a5), p10, O1); O1 = mfma32(VCAT(a6, a7), p11, O1); }
      return;
    }
#undef VREAD
#undef VCAT
    float ps = 0.f;
#pragma unroll
    for (int i = 0; i < 16; ++i) { S0[i] = __builtin_amdgcn_exp2f(S0[i]); S1[i] = __builtin_amdgcn_exp2f(S1[i]); ps += S0[i] + S1[i]; }
    l_run += ps;
    const bf16x8 p00 = pack8(S0[0], S0[1], S0[2], S0[3], S0[4], S0[5], S0[6], S0[7]);
    const bf16x8 p01 = pack8(S0[8], S0[9], S0[10], S0[11], S0[12], S0[13], S0[14], S0[15]);
    const bf16x8 p10 = pack8(S1[0], S1[1], S1[2], S1[3], S1[4], S1[5], S1[6], S1[7]);
    const bf16x8 p11 = pack8(S1[8], S1[9], S1[10], S1[11], S1[12], S1[13], S1[14], S1[15]);
#pragma unroll
    for (int ds = 0; ds < 2; ++ds) {
      const u16* vp = sVb + (32 * ds + r) * VLD + 4 * h;
      const s16x4 a0 = *(const s16x4*)(vp), a1 = *(const s16x4*)(vp + 8), a2 = *(const s16x4*)(vp + 16), a3 = *(const s16x4*)(vp + 24);
      const s16x4 a4 = *(const s16x4*)(vp + 32), a5 = *(const s16x4*)(vp + 40), a6 = *(const s16x4*)(vp + 48), a7 = *(const s16x4*)(vp + 56);
      const bf16x8 v00 = __builtin_shufflevector(a0, a1, 0, 1, 2, 3, 4, 5, 6, 7), v01 = __builtin_shufflevector(a2, a3, 0, 1, 2, 3, 4, 5, 6, 7);
      const bf16x8 v10 = __builtin_shufflevector(a4, a5, 0, 1, 2, 3, 4, 5, 6, 7), v11 = __builtin_shufflevector(a6, a7, 0, 1, 2, 3, 4, 5, 6, 7);
      if (ds == 0) { O0 = mfma32(v00, p00, O0); O0 = mfma32(v01, p01, O0); O0 = mfma32(v10, p10, O0); O0 = mfma32(v11, p11, O0); }
      else         { O1 = mfma32(v00, p00, O1); O1 = mfma32(v01, p01, O1); O1 = mfma32(v10, p10, O1); O1 = mfma32(v11, p11, O1); }
    }
  };
  const int nlast = nsteps - 1, npad = (MODE == 1 && it < 4096) ? 14 : ((nsteps + 1) & ~1);
  ATT_LOAD(a, 0);
  ATT_LOAD(b, min(1, nlast));
  for (int st = 0; st < npad; st += 2) {
    ATT_STORE(a, sK, sV);
    ATT_LOAD(a, min(st + 2, nlast));
    __syncthreads();
    compute(sK, sV, st);
    ATT_STORE(b, sK + SK_E, sV + SV_E);
    ATT_LOAD(b, min(st + 3, nlast));
    __syncthreads();
    compute(sK + SK_E, sV + SV_E, st + 1);
  }
#undef ATT_LOAD
#undef ATT_STORE
  {
    const float inv = 1.f / swapsum(l_run);
    const size_t mrow = (size_t)b * TB + tq;
    const u16* gp; u16* op = (u16*)(p.ws + OFF_H) + mrow * 1024 + hd * 64 + 4 * h;
    if (MODE == 0) gp = (const u16*)(p.ws + OFF_ZE) + mrow * 2048 + 416 + hd * 64 + 4 * h;
    else gp = (const u16*)(p.ws + OFF_ZO) + mrow * 3072 + 2048 + hd * 64 + 4 * h;
#pragma unroll
    for (int ds = 0; ds < 2; ++ds)
#pragma unroll
      for (int g = 0; g < 4; ++g) {
        const uint2 gv = *(const uint2*)(gp + 32 * ds + 8 * g);
        const float o0 = (ds ? O1[4 * g] : O0[4 * g]) * inv, o1 = (ds ? O1[4 * g + 1] : O0[4 * g + 1]) * inv;
        const float o2 = (ds ? O1[4 * g + 2] : O0[4 * g + 2]) * inv, o3 = (ds ? O1[4 * g + 3] : O0[4 * g + 3]) * inv;
        uint2 w = {pk2(o0 * silu(bflo(gv.x)), o1 * silu(bfhi(gv.x))), pk2(o2 * silu(bflo(gv.y)), o3 * silu(bfhi(gv.y)))};
        *(uint2*)(op + 32 * ds + 8 * g) = w;
      }
  }
  __syncthreads();
}


DI void mla_item8(const Params& p, int li, int it, char* smem) {
  constexpr int KLD = 104, KS = 6, VLD = 68, SK_E = 64 * KLD, SV_E = 64 * VLD;
  u16* sK = (u16*)smem;
  u16* sV = sK + 4 * SK_E;
  int tid = threadIdx.x; asm volatile("" : "+v"(tid));
  const int lane = tid & 63, wid = tid >> 6, r = lane & 31, h = lane >> 5;
  int bh, tqb, nsteps;
  if (it < 1024) { const int ch = it >> 8, w = it & 255; bh = ch * 8 + (w & 7); tqb = CTX + (w >> 3) * 256; nsteps = NCH; }
  else { bh = it - 1024; tqb = 0; nsteps = CTX / 64; }
  const int b = bh >> 3, hd = bh & 7;
  const int tq = tqb + wid * 32 + r;
  const u16* Qp = (const u16*)(p.ws + OFF_Q) + ((size_t)bh * TB + tq) * 96 + 8 * h;
  bf16x8 qf[KS];
#pragma unroll
  for (int s = 0; s < KS; ++s) qf[s] = *(const bf16x8*)(Qp + 16 * s);
  const int lkey = tid >> 3, lc8 = (tid & 7) * 8;
  const int rkey = tid >> 2, rc8 = (tid & 3) * 8;
  const u16* gK = (const u16*)(p.ws + OFF_KN) + ((size_t)bh * TB + lkey) * 64 + lc8;
  const u16* gR = (const u16*)(p.ws + OFF_KR) + ((size_t)b * TB + rkey) * 32 + rc8;
  const u16* gV = (const u16*)(p.ws + OFF_VTE) + ((size_t)bh * 64 + lkey) * TB + lc8;
  const int nlast = nsteps - 1;
  uint4 aK0, aK1, aR, aV0, aV1, bK0, bK1, bR, bV0, bV1;
#define LD_K(X, tile_) do { const int t0_ = min((tile_), nlast) * 64; \
    X##K0 = *(const uint4*)(gK + (size_t)t0_ * 64); if (wid < 4) X##R = *(const uint4*)(gR + (size_t)t0_ * 32); } while (0)
#define LD_V(X, tile_) do { const int t0_ = min((tile_), nlast) * 64; X##V0 = *(const uint4*)(gV + t0_); } while (0)
#define ST_K(X, kb_) do { u16* d_ = sK + (kb_) * SK_E; \
    *(uint4*)(d_ + lkey * KLD + lc8) = X##K0; if (wid < 4) *(uint4*)(d_ + rkey * KLD + 64 + rc8) = X##R; } while (0)
#define ST_V(X, vb_) do { u16* d_ = sV + (vb_) * SV_E; \
    *(uint2*)(d_ + lkey * VLD + lc8) = make_uint2(X##V0.x, X##V0.y); *(uint2*)(d_ + lkey * VLD + lc8 + 4) = make_uint2(X##V0.z, X##V0.w); } while (0)
  f32x16 O0, O1, NEGM;
#pragma unroll
  for (int i = 0; i < 16; ++i) { O0[i] = 0.f; O1[i] = 0.f; NEGM[i] = 0.f; }
  float m_run = 0.f, l_run = 0.f;
  constexpr float THR = 8.f;
  auto qk = [&](const u16* kb, f32x16& A0, f32x16& A1) {
    A0 = NEGM; A1 = NEGM;
#pragma unroll
    for (int s = 0; s < KS; ++s) {
      const bf16x8 k0 = *(const bf16x8*)(kb + r * KLD + 16 * s + 8 * h);
      const bf16x8 k1 = *(const bf16x8*)(kb + (32 + r) * KLD + 16 * s + 8 * h);
      A0 = mfma32(k0, qf[s], A0); A1 = mfma32(k1, qf[s], A1);
    }
  };
  auto check = [&](f32x16& A0, f32x16& A1, const bool first) {
    bool ex = false;
#pragma unroll
    for (int i = 0; i < 16; ++i) ex |= (A0[i] > THR) | (A1[i] > THR);
    if (__any(ex) || first) {
      float pm = fmaxf(A0[0], A1[0]);
#pragma unroll
      for (int i = 1; i < 16; ++i) pm = fmaxf(pm, fmaxf(A0[i], A1[i]));
      pm = swapmax(pm);
      const float delta = first ? pm : fmaxf(pm, 0.f);
      const float al = first ? 1.f : __builtin_amdgcn_exp2f(-delta);
      m_run += delta; l_run *= al;
#pragma unroll
      for (int i = 0; i < 16; ++i) { O0[i] *= al; O1[i] *= al; A0[i] -= delta; A1[i] -= delta; NEGM[i] = -m_run; }
    }
  };
  auto smpv = [&](f32x16& A0, f32x16& A1, const u16* vb) {
    float ps = 0.f;
#pragma unroll
    for (int i = 0; i < 16; ++i) { A0[i] = __builtin_amdgcn_exp2f(A0[i]); A1[i] = __builtin_amdgcn_exp2f(A1[i]); ps += A0[i] + A1[i]; }
    l_run += ps;
    const bf16x8 p00 = pack8(A0[0], A0[1], A0[2], A0[3], A0[4], A0[5], A0[6], A0[7]);
    const bf16x8 p01 = pack8(A0[8], A0[9], A0[10], A0[11], A0[12], A0[13], A0[14], A0[15]);
    const bf16x8 p10 = pack8(A1[0], A1[1], A1[2], A1[3], A1[4], A1[5], A1[6], A1[7]);
    const bf16x8 p11 = pack8(A1[8], A1[9], A1[10], A1[11], A1[12], A1[13], A1[14], A1[15]);
#pragma unroll
    for (int ds = 0; ds < 2; ++ds) {
      const u16* vp = vb + (32 * ds + r) * VLD + 4 * h;
      const s16x4 a0 = *(const s16x4*)(vp), a1 = *(const s16x4*)(vp + 8), a2 = *(const s16x4*)(vp + 16), a3 = *(const s16x4*)(vp + 24);
      const s16x4 a4 = *(const s16x4*)(vp + 32), a5 = *(const s16x4*)(vp + 40), a6 = *(const s16x4*)(vp + 48), a7 = *(const s16x4*)(vp + 56);
      const bf16x8 v00 = __builtin_shufflevector(a0, a1, 0, 1, 2, 3, 4, 5, 6, 7), v01 = __builtin_shufflevector(a2, a3, 0, 1, 2, 3, 4, 5, 6, 7);
      const bf16x8 v10 = __builtin_shufflevector(a4, a5, 0, 1, 2, 3, 4, 5, 6, 7), v11 = __builtin_shufflevector(a6, a7, 0, 1, 2, 3, 4, 5, 6, 7);
      if (ds == 0) { O0 = mfma32(v00, p00, O0); O0 = mfma32(v01, p01, O0); O0 = mfma32(v10, p10, O0); O0 = mfma32(v11, p11, O0); }
      else         { O1 = mfma32(v00, p00, O1); O1 = mfma32(v01, p01, O1); O1 = mfma32(v10, p10, O1); O1 = mfma32(v11, p11, O1); }
    }
  };
  LD_K(a, 0); LD_V(a, 0); LD_K(b, 1); LD_V(b, 1);
  ST_K(a, 0); ST_V(a, 0); ST_K(b, 1); ST_V(b, 1);
  LD_K(a, 2);
  ST_K(a, 2);
  LD_K(a, 3); LD_V(a, 2); LD_K(b, 4); LD_V(b, 3);
  __syncthreads();
  f32x16 Sc0, Sc1, Sn0, Sn1;
  qk(sK, Sc0, Sc1);
  check(Sc0, Sc1, true);
  __syncthreads();
  for (int j = 0; j < nsteps; j += 4) {
    ST_K(a, 3); ST_V(a, 2);
    LD_K(a, j + 5); LD_V(a, j + 4);
    qk(sK + 1 * SK_E, Sn0, Sn1);  smpv(Sc0, Sc1, sV + 0 * SV_E);  check(Sn0, Sn1, false);
    ST_K(b, 0); ST_V(b, 3);
    LD_K(b, j + 6); LD_V(b, j + 5);
    qk(sK + 2 * SK_E, Sc0, Sc1);  smpv(Sn0, Sn1, sV + 1 * SV_E);  check(Sc0, Sc1, false);
    __syncthreads();
    ST_K(a, 1); ST_V(a, 0);
    LD_K(a, j + 7); LD_V(a, j + 6);
    qk(sK + 3 * SK_E, Sn0, Sn1);  smpv(Sc0, Sc1, sV + 2 * SV_E);  check(Sn0, Sn1, false);
    ST_K(b, 2); ST_V(b, 1);
    LD_K(b, j + 8); LD_V(b, j + 7);
    qk(sK + 0 * SK_E, Sc0, Sc1);  smpv(Sn0, Sn1, sV + 3 * SV_E);  check(Sc0, Sc1, false);
    __syncthreads();
  }
#undef LD_K
#undef LD_V
#undef ST_K
#undef ST_V
  {
    const float inv = 1.f / swapsum(l_run);
    const size_t mrow = (size_t)b * TB + tq;
    u16* op = (u16*)(p.ws + OFF_H) + mrow * 1024 + hd * 64 + 4 * h;
    const u16* gp = (const u16*)(p.ws + OFF_ZE) + mrow * 2048 + 416 + hd * 64 + 4 * h;
#pragma unroll
    for (int ds = 0; ds < 2; ++ds)
#pragma unroll
      for (int g = 0; g < 4; ++g) {
        const uint2 gv = *(const uint2*)(gp + 32 * ds + 8 * g);
        const float o0 = (ds ? O1[4 * g] : O0[4 * g]) * inv, o1 = (ds ? O1[4 * g + 1] : O0[4 * g + 1]) * inv;
        const float o2 = (ds ? O1[4 * g + 2] : O0[4 * g + 2]) * inv, o3 = (ds ? O1[4 * g + 3] : O0[4 * g + 3]) * inv;
        uint2 w = {pk2(o0 * silu(bflo(gv.x)), o1 * silu(bfhi(gv.x))), pk2(o2 * silu(bflo(gv.y)), o3 * silu(bfhi(gv.y)))};
        *(uint2*)(op + 32 * ds + 8 * g) = w;
      }
  }
  __syncthreads();
}

DI void phase_e3(const Params& p, int li, char* smem) {
  constexpr int N_MLA = 2048 + 64, N_LRU = NB * NCH * 8;
  const bool lru_first = lbid() >= (VGRID >> 1);
  for (int stage = 0; stage < 2; ++stage) {
    if ((stage == 0) == lru_first) {
      for (int it = lbid(); it < N_LRU; it += VGRID) lru_item<3>(p, li, it, smem);
    } else {
      for (int it = pbid(); it < 1024 + 32; it += (int)gridDim.x) mla_item8(p, li, it, smem - lhalf() * 65536);
    }
  }
}
DI void phase_na(const Params& p, int li, int nitems, char* smem) {
  for (int it = lbid(); it < nitems; it += VGRID) attn_item<1>(p, li, it, smem);
}


namespace pg8 {
#define PG8_LAS __attribute__((address_space(3)))
typedef unsigned short bf16_t;
typedef short bf16x8 __attribute__((ext_vector_type(8)));
typedef float f32x4 __attribute__((ext_vector_type(4)));
typedef unsigned u32x4 __attribute__((ext_vector_type(4)));
constexpr int BM = 256, BK = 64, HALF = 128, HTB = HALF * BK * 2  , STAGE_BYTES = 8 * HTB, NXCD = 8, WGM = 8;

__host__ __device__ __forceinline__ int lds_byte(int r, int c) { const int st = (r >> 4) * 2 + (c >> 5), rr = r & 15, cc = c & 31, ob = rr * 64 + cc * 2; return st * 1024 + (ob ^ (((ob >> 9) & 1) << 5)); }
__host__ __device__ __forceinline__ void stage_rc(int b, int& R, int& C) { const int st = b / 1024, sb = b % 1024, swz = sb ^ (((sb >> 9) & 1) << 5); R = (st >> 1) * 16 + swz / 64; C = (st & 1) * 32 + (swz % 64) / 2; }
__host__ __device__ __forceinline__ int perm32(int rho) { const int n = rho >> 4, i = rho & 15; return 8 * (i >> 2) + 4 * n + (i & 3); }

struct Unit { int pm, pn, kind; };
struct Gemm { const bf16_t* A; const bf16_t* Bt; int M, N, K; };
struct StaticOrder {
    int nM, nN, nwg, G, c;
    __host__ __device__ void init(int M, int N, int G_, int c_) { nM = M / BM; nN = N / BM; nwg = nM * nN; G = G_; c = c_; }
    __host__ __device__ bool next(int i, Unit& u) const { return at((long)i * G + c, u); }
    __device__ __forceinline__ const char* aptr(const Gemm& g, const Unit& u, size_t tstep) const { return (const char*)g.A + (size_t)u.pm * tstep; }
    __device__ __forceinline__ const char* bptr(const Gemm& g, const Unit& u, size_t tstep) const { return (const char*)g.Bt + (size_t)u.pn * tstep; }
    __host__ __device__ bool at(long L, Unit& u) const {
        u.kind = 0; if (L >= nwg) return false;
        int wgid = (int)L; { const int q = nwg / NXCD, r = nwg % NXCD, xcd = wgid % NXCD, off = wgid / NXCD; wgid = (xcd < r ? xcd * (q + 1) : r * (q + 1) + (xcd - r) * q) + off; }
        const int nig = WGM * nN, gid = wgid / nig, fm = gid * WGM, gsz = (nM - fm) < WGM ? (nM - fm) : WGM;
        u.pm = fm + ((wgid % nig) % gsz); u.pn = (wgid % nig) / gsz; return true;
    }
    __device__ __forceinline__ void a_ready(const Unit&) const {}
    __device__ __forceinline__ void done(const Unit&) const {}
};

__device__ __forceinline__ unsigned pk2f(float a, float b) { typedef __bf16 b2 __attribute__((ext_vector_type(2))); typedef float f2 __attribute__((ext_vector_type(2)));
    f2 f = {a, b}; b2 r = __builtin_convertvector(f, b2); return __builtin_bit_cast(unsigned, r); }
struct EpiStoreBf16 {
    static constexpr bool PERM = true, AFTER_DRAIN = false;
    bf16_t* O; int ldc; int split_cols; size_t split_stride;
    __device__ __forceinline__ void operator()(const f32x4 (&acc)[2][2][4][2], const Unit& u, int wr, int wc, int fr, int fq) const {
        const int row0 = u.pm * BM + wr * 64 + fr; int colt = u.pn * BM; bf16_t* base = O;
        if (split_cols) { const int t = colt / split_cols; base += (size_t)t * split_stride; colt -= t * split_cols; }
        const int col0 = colt + wc * 32 + 8 * fq;
#pragma unroll
        for (int ai = 0; ai < 2; ++ai)
#pragma unroll
            for (int m = 0; m < 4; ++m) { bf16_t* rowp = base + (size_t)(row0 + ai * HALF + m * 16) * ldc + col0;
#pragma unroll
                for (int bj = 0; bj < 2; ++bj) { const f32x4 v0 = acc[ai][bj][m][0], v1 = acc[ai][bj][m][1];
                    u32x4 w; w.x = pk2f(v0[0], v0[1]); w.y = pk2f(v0[2], v0[3]); w.z = pk2f(v1[0], v1[1]); w.w = pk2f(v1[2], v1[3]);
                    *(u32x4*)(rowp + bj * HALF) = w; } }
    }
};
struct EpiResid {
    static constexpr bool PERM = true, AFTER_DRAIN = false;
    const float* x_in; const float* ctx_in; const bf16_t* xb_in; bf16_t* xb_out; float* out32; const float* gate0; int L;
    __device__ __forceinline__ void operator()(const f32x4 (&acc)[2][2][4][2], const Unit& u, int wr, int wc, int fr, int fq) const {
        const int b = u.pm / 33, pt = u.pm - b * 33; const bool isctx = pt == 0;
        const float* gate = gate0 + (size_t)(isctx ? 4 : b) * 3072;
        const int col0 = u.pn * BM + wc * 32 + 8 * fq;
#pragma unroll
        for (int bj = 0; bj < 2; ++bj) {
            const int c = col0 + bj * HALF;
            const f32x4 g0 = *(const f32x4*)(gate + c), g1 = *(const f32x4*)(gate + c + 4);
#pragma unroll
            for (int ai = 0; ai < 2; ++ai)
#pragma unroll
                for (int m = 0; m < 4; ++m) {
                    const int lrow = wr * 64 + fr + ai * HALF + m * 16, t = pt * 256 + lrow;
                    const size_t grow = (size_t)u.pm * BM + lrow;
                    f32x4 x0, x1;
                    if (L == 0) { const float* src32 = (isctx ? ctx_in + ((size_t)b * 256 + t) * 1024 : x_in + ((size_t)b * 8192 + (t - 256)) * 1024) + c;
                        x0 = *(const f32x4*)(src32); x1 = *(const f32x4*)(src32 + 4); }
                    else { const u32x4 w = *(const u32x4*)(xb_in + grow * 1024 + c);
                        x0 = (f32x4){__uint_as_float(w.x << 16), __uint_as_float(w.x & 0xffff0000u), __uint_as_float(w.y << 16), __uint_as_float(w.y & 0xffff0000u)};
                        x1 = (f32x4){__uint_as_float(w.z << 16), __uint_as_float(w.z & 0xffff0000u), __uint_as_float(w.w << 16), __uint_as_float(w.w & 0xffff0000u)}; }
                    const f32x4 y0 = x0 + g0 * acc[ai][bj][m][0], y1 = x1 + g1 * acc[ai][bj][m][1];
                    if (L == 3) { float* dst32 = out32 + ((size_t)b * 8192 + (t - 256)) * 1024 + c; *(f32x4*)(dst32) = y0; *(f32x4*)(dst32 + 4) = y1; }
                    else { u32x4 w; w.x = pk2f(y0[0], y0[1]); w.y = pk2f(y0[2], y0[3]); w.z = pk2f(y1[0], y1[1]); w.w = pk2f(y1[2], y1[3]); *(u32x4*)(xb_out + grow * 1024 + c) = w; }
                }
        }
    }
};
struct LatentOrder {
    int G, c;
    __device__ bool next(int i, Unit& u) const { const int Lx = i * G + c; if (Lx >= 512) return false; const int lm = Lx >> 2; u.kind = 0; u.pn = Lx & 3; u.pm = (lm >> 5) * 33 + 1 + (lm & 31); return true; }
    __device__ __forceinline__ const char* aptr(const Gemm& g, const Unit& u, size_t tstep) const { return (const char*)g.A + (size_t)u.pm * tstep; }
    __device__ __forceinline__ const char* bptr(const Gemm& g, const Unit& u, size_t tstep) const { return (const char*)g.Bt + (size_t)u.pn * tstep; }
    __device__ __forceinline__ void a_ready(const Unit&) const {}
    __device__ __forceinline__ void done(const Unit&) const {}
};


struct OddOrder {
    StaticOrder s0, s1; const bf16_t* h; const bf16_t* W; int G, c;
    __device__ void init(const bf16_t* h_, const bf16_t* W_, int G_, int c_) { h = h_; W = W_; G = G_; c = c_; s0.init(33792, 3072, G_, c_); s1.init(1024, 33792, G_, c_); }
    __device__ bool next(int i, Unit& u) const { const long L = (long)i * G + c; if (L < s0.nwg) return s0.at(L, u); if (!s1.at(L - s0.nwg, u)) return false; u.kind = 1; return true; }
    __device__ __forceinline__ const char* aptr(const Gemm&, const Unit& u, size_t tstep) const { return (const char*)(u.kind ? W + (size_t)3072 * 1024 : h) + (size_t)u.pm * tstep; }
    __device__ __forceinline__ const char* bptr(const Gemm&, const Unit& u, size_t tstep) const { return (const char*)(u.kind ? h : W) + (size_t)u.pn * tstep; }
    __device__ __forceinline__ void a_ready(const Unit&) const {}
    __device__ __forceinline__ void done(const Unit&) const {}
};
struct EpiOdd {
    static constexpr bool PERM = true, AFTER_DRAIN = false;
    EpiStoreBf16 e0, e1;
    __device__ __forceinline__ void operator()(const f32x4 (&acc)[2][2][4][2], const Unit& u, int wr, int wc, int fr, int fq) const {
        if (u.kind) e1(acc, u, wr, wc, fr, fq); else e0(acc, u, wr, wc, fr, fq);
    }
};
template <class Epi, class Sched, bool STAMP = false>
__device__ __forceinline__ void gemm_phase(PG8_LAS unsigned char* lds, const Gemm g, const Sched& S, const Epi& E, unsigned long long* stamps) {
    int tid = threadIdx.x; asm volatile("" : "+v"(tid));
    const int wid = __builtin_amdgcn_readfirstlane(tid >> 6), lane = tid & 63, wr = wid >> 2, wc = wid & 3, fr = lane & 15, fq = lane >> 4;
    const int K = g.K, nt = K / BK;
    int ts_lo = 0, ts_hi = 0, nts = 0; const unsigned long long rt_entry = STAMP ? 0ull : 0ull;
#define PG8_STAMP() do { if (STAMP && wid == 0 && nts < 64) { const unsigned long long _c = 0ull; \
        ts_lo = (lane == nts) ? (int)(unsigned)_c : ts_lo; ts_hi = (lane == nts) ? (int)(unsigned)(_c >> 32) : ts_hi; ++nts; } } while (0)
    PG8_STAMP();
    unsigned voffA[2], voffB[2];
#pragma unroll
    for (int i = 0; i < 2; ++i) { int R, C; stage_rc(tid * 16 + i * 8192, R, C); const int Rb = Epi::PERM ? ((R & ~31) + perm32(R & 31)) : R;
        voffA[i] = (unsigned)(R * K + C) * 2u; voffB[i] = (unsigned)(Rb * K + C) * 2u; }
    const size_t kstep = (size_t)(BK * 2);
    const size_t hstep = (size_t)HALF * K * 2;
    const size_t tstep = 2 * hstep;
    const unsigned ldsw = (unsigned)wid * 1024u;
    const int aoff = lds_byte(wr * 64 + fr, fq * 8), boff = lds_byte(wc * 32 + fr, fq * 8);
#define PG8_SA(b, h) (((b) * 2 + (h)) * HTB)
#define PG8_SB(b, h) ((4 + (b) * 2 + (h)) * HTB)
#define PG8_STAGE(bufoff, gbase, voff) do { _Pragma("unroll") for (int _i = 0; _i < 2; ++_i) \
        __builtin_amdgcn_global_load_lds((const unsigned*)((const char*)(gbase) + (voff)[_i]), (PG8_LAS unsigned*)(lds + (bufoff) + ldsw + _i * 8192), 16, 0, 0); } while (0)
#define PG8_LDA(dst, b, h) do { _Pragma("unroll") for (int m = 0; m < 4; ++m) _Pragma("unroll") for (int k = 0; k < 2; ++k) dst[m][k] = *(const PG8_LAS bf16x8*)(lds + PG8_SA(b, h) + aoff + m * 2048 + k * 1024); } while (0)
#define PG8_LDB(dst, b, h) do { _Pragma("unroll") for (int n = 0; n < 2; ++n) _Pragma("unroll") for (int k = 0; k < 2; ++k) dst[n][k] = *(const PG8_LAS bf16x8*)(lds + PG8_SB(b, h) + boff + n * 2048 + k * 1024); } while (0)
#define PG8_MMA(ai, bj, At, Bt) do { __builtin_amdgcn_s_setprio(1); _Pragma("unroll") for (int m = 0; m < 4; ++m) _Pragma("unroll") for (int n = 0; n < 2; ++n) _Pragma("unroll") for (int k = 0; k < 2; ++k) \
        acc[ai][bj][m][n] = __builtin_amdgcn_mfma_f32_16x16x32_bf16(Bt[n][k], At[m][k], acc[ai][bj][m][n], 0, 0, 0); __builtin_amdgcn_s_setprio(0); } while (0)
#define PG8_WAIT_V(n) asm volatile("s_waitcnt vmcnt(" #n ")" ::: "memory")
#define PG8_WAIT_L(n) asm volatile("s_waitcnt lgkmcnt(" #n ")" ::: "memory")
#define PG8_BAR __builtin_amdgcn_s_barrier()
#define PG8_SCHED __builtin_amdgcn_sched_barrier(0)
    Unit cur, nxt; int ui = 0;
    if (!S.next(0, cur)) return;
    f32x4 acc[2][2][4][2];
#pragma unroll
    for (int a = 0; a < 2; ++a)
#pragma unroll
        for (int b = 0; b < 2; ++b)
#pragma unroll
            for (int m = 0; m < 4; ++m)
#pragma unroll
                for (int n = 0; n < 2; ++n) acc[a][b][m][n] = (f32x4){0.f, 0.f, 0.f, 0.f};
    bf16x8 At[4][2], B0[2][2], B1[2][2];
    const char* cA = S.aptr(g, cur, tstep); const char* cB = S.bptr(g, cur, tstep);
    S.a_ready(cur);
    PG8_STAGE(PG8_SB(0, 0), cB, voffB); PG8_STAGE(PG8_SA(0, 0), cA, voffA); PG8_STAGE(PG8_SB(0, 1), cB + hstep, voffB); PG8_STAGE(PG8_SA(0, 1), cA + hstep, voffA);
    if (wr == 1) PG8_BAR;
    PG8_WAIT_V(4); PG8_BAR;
    PG8_STAGE(PG8_SB(1, 0), cB + kstep, voffB); PG8_STAGE(PG8_SA(1, 0), cA + kstep, voffA); PG8_STAGE(PG8_SB(1, 1), cB + hstep + kstep, voffB);
    PG8_WAIT_V(6); PG8_BAR;
    PG8_STAMP();
    for (;;) {
        const bool has_next = S.next(ui + 1, nxt);
        const char* nA = has_next ? S.aptr(g, nxt, tstep) : cA; const char* nB = has_next ? S.bptr(g, nxt, tstep) : cB;
        for (int t = 0; t < nt; t += 2) {
            const bool last = (t == nt - 2);
            const char* a1 = cA + (size_t)(t + 1) * kstep;
            const char* a2 = last ? nA : cA + (size_t)(t + 2) * kstep; const char* b2 = last ? nB : cB + (size_t)(t + 2) * kstep;
            const char* a3 = a2 + kstep; const char* b3 = b2 + kstep;
            if (last && has_next) S.a_ready(nxt);
            PG8_LDB(B0, 0, 0); PG8_SCHED; PG8_LDA(At, 0, 0); PG8_STAGE(PG8_SA(1, 1), a1 + hstep, voffA);
            PG8_WAIT_L(8); PG8_BAR; PG8_WAIT_L(0); PG8_MMA(0, 0, At, B0); PG8_BAR; PG8_SCHED;
            PG8_LDB(B1, 0, 1); PG8_STAGE(PG8_SB(0, 0), b2, voffB);
            PG8_BAR; PG8_WAIT_L(0); PG8_MMA(0, 1, At, B1); PG8_BAR;
            PG8_LDA(At, 0, 1); PG8_STAGE(PG8_SA(0, 0), a2, voffA);
            PG8_BAR; PG8_WAIT_L(0); PG8_MMA(1, 0, At, B0); PG8_BAR; PG8_SCHED;
            PG8_STAGE(PG8_SB(0, 1), b2 + hstep, voffB);
            PG8_WAIT_V(6); PG8_BAR; PG8_MMA(1, 1, At, B1); PG8_BAR;
            PG8_LDB(B0, 1, 0); PG8_SCHED; PG8_LDA(At, 1, 0); PG8_STAGE(PG8_SA(0, 1), a2 + hstep, voffA);
            PG8_WAIT_L(8); PG8_BAR; PG8_WAIT_L(0); PG8_MMA(0, 0, At, B0); PG8_BAR; PG8_SCHED;
            PG8_LDB(B1, 1, 1); PG8_STAGE(PG8_SB(1, 0), b3, voffB);
            PG8_BAR; PG8_WAIT_L(0); PG8_MMA(0, 1, At, B1); PG8_BAR;
            PG8_LDA(At, 1, 1); PG8_STAGE(PG8_SA(1, 0), a3, voffA);
            PG8_BAR; PG8_WAIT_L(0); PG8_MMA(1, 0, At, B0); PG8_BAR; PG8_SCHED;
            PG8_STAGE(PG8_SB(1, 1), b3 + hstep, voffB);
            PG8_WAIT_V(6); PG8_BAR; PG8_MMA(1, 1, At, B1); PG8_BAR;
        }
        PG8_STAMP();
        if constexpr (!Epi::AFTER_DRAIN) { E(acc, cur, wr, wc, fr, fq); S.done(cur); }
        PG8_STAMP();
        if (!has_next) break;
#pragma unroll
        for (int a = 0; a < 2; ++a)
#pragma unroll
            for (int b = 0; b < 2; ++b)
#pragma unroll
                for (int m = 0; m < 4; ++m)
#pragma unroll
                    for (int n = 0; n < 2; ++n) acc[a][b][m][n] = (f32x4){0.f, 0.f, 0.f, 0.f};
        cur = nxt; cA = nA; cB = nB; ++ui;
    }
    PG8_WAIT_V(0);
    if (wr == 0) PG8_BAR;
    PG8_BAR;
    if constexpr (Epi::AFTER_DRAIN) { E.fused(acc, cur, wr, wc, fr, fq, lds, wid, lane); S.done(cur); }
    PG8_STAMP();
    if (STAMP && wid == 0) { stamps[lane] = lane < nts ? (((unsigned long long)(unsigned)ts_hi << 32) | (unsigned)ts_lo) : 0ull;
        if (lane == 62) stamps[62] = rt_entry; if (lane == 63) stamps[63] = 0ull; }
#undef PG8_STAMP
#undef PG8_SA
#undef PG8_SB
#undef PG8_STAGE
#undef PG8_LDA
#undef PG8_LDB
#undef PG8_MMA
#undef PG8_WAIT_V
#undef PG8_WAIT_L
#undef PG8_BAR
#undef PG8_SCHED
}
}


DI void phase_win_even8(const Params& p, int li, char* lds) {
  pg8::Gemm g{(const u16*)(p.ws + OFF_H), (const u16*)(p.ws + OFF_WINE + li * SZ_WINE), M, 2048, 1024};
  pg8::StaticOrder S; S.init(g.M, g.N, (int)gridDim.x, pbid());
  pg8::EpiStoreBf16 E{(u16*)(p.ws + OFF_ZE), 2048, 0, 0};
  pg8::gemm_phase<pg8::EpiStoreBf16, pg8::StaticOrder, false>((PG8_LAS unsigned char*)lds, g, S, E, nullptr);
}
DI void phase_win_odd8(const Params& p, int li, char* lds) {
  const u16* W = (const u16*)(p.ws + OFF_WINO + li * SZ_WINO);
  const u16* h = (const u16*)(p.ws + OFF_H);
  pg8::Gemm g{h, W, M, 3072, 1024};
  pg8::OddOrder S; S.init(h, W, (int)gridDim.x, pbid());
  pg8::EpiOdd E{pg8::EpiStoreBf16{(u16*)(p.ws + OFF_ZO), 3072, 0, 0}, pg8::EpiStoreBf16{(u16*)(p.ws + OFF_VTO), TB, TB, (size_t)1024 * TB}};
  pg8::gemm_phase<pg8::EpiOdd, pg8::OddOrder, false>((PG8_LAS unsigned char*)lds, g, S, E, nullptr);
}
DI void phase_out8(const Params& p, int L, char* lds) {
  const int li = L >> 1;
  pg8::Gemm g{(const u16*)(p.ws + OFF_H), (const u16*)(p.ws + ((L & 1) ? OFF_WOUTO : OFF_WOUTE) + li * SZ_WOUT), M, 1024, 1024};
  pg8::EpiResid E{p.x, p.ctx, (const u16*)(p.ws + OFF_XB), (u16*)(p.ws + OFF_XB), p.out, (const float*)(p.ws + OFF_MOD) + (size_t)L * 5 * 3072 + 2048, L};
  if (L == 3) {
    pg8::LatentOrder S{(int)gridDim.x, pbid()};
    pg8::gemm_phase<pg8::EpiResid, pg8::LatentOrder, false>((PG8_LAS unsigned char*)lds, g, S, E, nullptr);
  } else {
    pg8::StaticOrder S; S.init(g.M, g.N, (int)gridDim.x, pbid());
    pg8::gemm_phase<pg8::EpiResid, pg8::StaticOrder, false>((PG8_LAS unsigned char*)lds, g, S, E, nullptr);
  }
}

#define XB_TMO      128
#define XB_XCNT(j)  (256  + 64 * (j))
#define XB_XSUB(j)  (1280 + 64 * (j))
#define XB_XGEN(j)  (2304 + 64 * (j))
#define XB_TOP      3328
#define XB_TOPGEN   3392
#define XCD_BAR_WORDS 3456
#define XB_SPIN_CAP (1u << 22)
#define LAS __attribute__((address_space(3)))
DI unsigned xb_ld(unsigned* p)              { return __hip_atomic_load(p, __ATOMIC_RELAXED, __HIP_MEMORY_SCOPE_AGENT); }
DI unsigned xb_add(unsigned* p, unsigned v) { return __hip_atomic_fetch_add(p, v, __ATOMIC_RELAXED, __HIP_MEMORY_SCOPE_AGENT); }
DI unsigned xb_xcc_id() { return (unsigned)__builtin_amdgcn_s_getreg((3 << 11) | 20) & 0xFu; }
#define XB_SPIN(cond, bar) do { unsigned _sp = 0; while (cond) { __builtin_amdgcn_s_sleep(1); \
    if ((++_sp & 255u) == 0u) { if (xb_ld(&(bar)[XB_TMO])) break; if (_sp > XB_SPIN_CAP) { atomicAdd(&(bar)[XB_TMO], 1u); break; } } } } while (0)
struct XcdBarrier { unsigned* bar; unsigned x; volatile LAS unsigned* st; };
DI XcdBarrier xcd_barrier_post(unsigned* bar, volatile LAS unsigned* st) {
  XcdBarrier b; b.bar = bar; b.x = xb_xcc_id(); b.st = st;
  if (threadIdx.x == 0) (void)xb_add(&bar[XB_XCNT(b.x)], 1u);
  return b;
}
DI void xcd_barrier_complete(unsigned* bar, unsigned x, unsigned& nloc, unsigned& nx) {
  const unsigned G = gridDim.x * gridDim.y * gridDim.z;
  unsigned sum, cnt, mine, sp = 0u;
  for (;;) {
    sum = 0u; cnt = 0u; mine = 0u;
#pragma unroll
    for (unsigned j = 0; j < 16; ++j) { const unsigned c = xb_ld(&bar[XB_XCNT(j)]); sum += c; cnt += (c > 0u) ? 1u : 0u; mine = (j == x) ? c : mine; }
    if (sum == G) break;
    __builtin_amdgcn_s_sleep(1);
    if ((++sp & 255u) == 0u) { if (xb_ld(&bar[XB_TMO])) break; if (sp > XB_SPIN_CAP) { atomicAdd(&bar[XB_TMO], 1u); break; } }
  }
  nloc = mine > 0u ? mine : 1u; nx = cnt > 0u ? cnt : 1u;
}
DI void xcd_barrier(const XcdBarrier& b) {
  asm volatile("s_waitcnt vmcnt(0)" ::: "memory");
  __syncthreads();
  if (threadIdx.x == 0) {
    unsigned* bar = b.bar;
    __builtin_amdgcn_s_waitcnt(0);
    unsigned nloc = b.st[0], nx = b.st[1];
    if (nloc == 0u) { xcd_barrier_complete(bar, b.x, nloc, nx); b.st[0] = nloc; b.st[1] = nx; }
    const unsigned old = xb_add(&bar[XB_XSUB(b.x)], 1u);
    const unsigned gen = old / nloc;
    if (old + 1u == (gen + 1u) * nloc) {
      __builtin_amdgcn_fence(__ATOMIC_RELEASE, "agent");
      asm volatile("s_waitcnt vmcnt(0)" ::: "memory");
      const unsigned og = xb_add(&bar[XB_TOP], 1u);
      const unsigned tg = og / nx;
      if (og + 1u == (tg + 1u) * nx) xb_add(&bar[XB_TOPGEN], 1u);
      else XB_SPIN(xb_ld(&bar[XB_TOPGEN]) == tg, bar);
      __builtin_amdgcn_fence(__ATOMIC_ACQUIRE, "agent");
      xb_add(&bar[XB_XGEN(b.x)], 1u);
      asm volatile("s_waitcnt vmcnt(0)" ::: "memory");
    } else {
      XB_SPIN(xb_ld(&bar[XB_XGEN(b.x)]) == gen, bar);
      __builtin_amdgcn_fence(__ATOMIC_ACQUIRE, "agent");
      asm volatile("s_waitcnt vmcnt(0)" ::: "memory");
    }
  }
  __syncthreads();
}

DI void phase_lru_carry(const Params& p) {
  float* aggA = (float*)(p.ws + OFF_AGGA);
  float* aggH = (float*)(p.ws + OFF_AGGH);
  const int g = lbid() * 256 + ltid();
  if (g >= NB * 2 * 512) return;
  const int b = g >> 10, d = (g >> 9) & 1, c = g & 511;
  const size_t ob = (size_t)b * NCH * 1024 + d * 512 + c;
  float hh = 0.f;
  for (int s0 = 0; s0 < NCH; s0 += 12) {
    float a[12], hv[12]; size_t o[12];
#pragma unroll
    for (int u = 0; u < 12; ++u) {
      const int s = s0 + u;
      const int j = d == 0 ? s : (s < 4 ? 3 - s : NCH + 3 - s);
      o[u] = ob + (size_t)j * 1024; a[u] = aggA[o[u]]; hv[u] = aggH[o[u]];
    }
#pragma unroll
    for (int u = 0; u < 12; ++u) { aggH[o[u]] = hh; hh = a[u] * hh + hv[u]; }
  }
}

#ifndef DUP
#define DUP 0
#endif
#define REP(k) for (int rep_ = 0; rep_ < ((DUP) == (k) ? 2 : 1); ++rep_)
constexpr int HALF_LDS = 65536;
constexpr int DYN_LDS = 2 * HALF_LDS + 16;
__global__ void __launch_bounds__(512, 2) mega(Params p) {
  extern __shared__ __attribute__((aligned(16))) char dyn_smem[];
  char* smem = dyn_smem + lhalf() * HALF_LDS;
  uint4* xbw = (uint4*)(dyn_smem + 2 * HALF_LDS);
  cg::grid_group grid = cg::this_grid();
  if (threadIdx.x == 0) *xbw = make_uint4(0u, 0u, 0u, 0u);
  __syncthreads();
  const XcdBarrier xbar = xcd_barrier_post((unsigned*)(p.ws + OFF_BAR), (volatile LAS unsigned*)xbw);
  REP(9) phase_prep(p, smem);
  grid.sync();
  for (int L = 0; L < NLAYERS_RUN; ++L) {
    const int li = L >> 1;
    REP(1) phase_norm(p, L);
    do { xcd_barrier(xbar); if (DUP == 10) xcd_barrier(xbar); } while (0);
    if ((L & 1) == 0) {
      REP(2) phase_win_even8(p, li, dyn_smem);
      do { xcd_barrier(xbar); if (DUP == 10) xcd_barrier(xbar); } while (0);
      REP(3) phase_e2(p, li, smem);
      do { xcd_barrier(xbar); if (DUP == 10) xcd_barrier(xbar); } while (0);
      phase_lru_carry(p);
      do { xcd_barrier(xbar); if (DUP == 10) xcd_barrier(xbar); } while (0);
      REP(4) phase_e3(p, li, smem);
      do { xcd_barrier(xbar); if (DUP == 10) xcd_barrier(xbar); } while (0);
    } else {
      REP(6) phase_win_odd8(p, li, dyn_smem);
      do { xcd_barrier(xbar); if (DUP == 10) xcd_barrier(xbar); } while (0);
      REP(7) phase_na(p, li, L < 3 ? 4096 + 128 : 4096, smem);
      do { xcd_barrier(xbar); if (DUP == 10) xcd_barrier(xbar); } while (0);
    }
    phase_out8(p, L, dyn_smem);
    do { xcd_barrier(xbar); if (DUP == 10) xcd_barrier(xbar); } while (0);
  }
  phase_final_norm(p);
}

extern "C" void kernel_launch(void* const* d_in, const int* in_sizes, int n_in, void* d_out, int out_size, void* d_ws, size_t ws_size,
                              hipStream_t stream) {
  static int grid_blocks = 0;
  if (!grid_blocks) {
    int dev = 0, cus = 0, per_cu = 0;
    (void)hipGetDevice(&dev);
    (void)hipDeviceGetAttribute(&cus, hipDeviceAttributeMultiprocessorCount, dev);
    if (hipFuncSetAttribute((const void*)mega, hipFuncAttributeMaxDynamicSharedMemorySize, DYN_LDS) != hipSuccess) { fprintf(stderr, "kernel_launch: hipFuncSetAttribute(%d B LDS) failed\n", DYN_LDS); return; }
    (void)hipOccupancyMaxActiveBlocksPerMultiprocessor(&per_cu, mega, 512, DYN_LDS);
    (void)hipGetLastError();
    grid_blocks = cus & ~7;
  }
  if (ws_size < WS_NEED) { fprintf(stderr, "kernel_launch: workspace too small: %zu < %zu\n", ws_size, WS_NEED); return; }
  if (hipMemsetAsync((char*)d_ws + OFF_BAR, 0, 16384, stream) != hipSuccess) { fprintf(stderr, "kernel_launch: memset failed\n"); return; }
  Params p{};
  const float** f = (const float**)&p;
  for (int i = 0; i < 24; ++i) f[i] = (const float*)d_in[i];
  p.out = (float*)d_out;
  p.ws = (char*)d_ws;
  void* args[] = {&p};
  hipError_t e = hipLaunchCooperativeKernel((void*)mega, dim3(grid_blocks), dim3(512), args, DYN_LDS, stream);
  if (e != hipSuccess) fprintf(stderr, "cooperative launch failed: %s (grid %d)\n", hipGetErrorString(e), grid_blocks);
}
```

```cpp
#include <hip/hip_runtime.h>
#include <hip/hip_cooperative_groups.h>
#include <cstdio>
namespace cg = cooperative_groups;

#define DI __device__ __forceinline__
typedef unsigned short u16;
using bf16x8 = __attribute__((ext_vector_type(8))) short;
using s16x4  = __attribute__((ext_vector_type(4))) short;
using f32x16 = __attribute__((ext_vector_type(16))) float;
typedef __bf16 bf2_t __attribute__((ext_vector_type(2)));
typedef float fl2_t __attribute__((ext_vector_type(2)));

#ifndef NLAYERS_RUN
#define NLAYERS_RUN 4
#endif

constexpr int D = 1024, NB = 4, SEQ = 8192, CTX = 256, TB = SEQ + CTX, M = NB * TB;
constexpr int NCH = TB / 64;
constexpr float LOG2E = 1.4426950408889634f;
constexpr float MLA_QS = 0.10206207261596575f * LOG2E;
constexpr float RMS_EPS = 1e-6f;

constexpr size_t SZ_WINE = (size_t)2048 * 1024 * 2, SZ_WUQ = (size_t)768 * 256 * 2, SZ_WUKV = (size_t)1024 * 128 * 2;
constexpr size_t SZ_WOUT = (size_t)1024 * 1024 * 2, SZ_WINO = (size_t)4096 * 1024 * 2, SZ_WLRU = (size_t)32 * 4096 * 2;
constexpr size_t OFF_WINE = 0;
constexpr size_t OFF_WUQ = OFF_WINE + 2 * SZ_WINE;
constexpr size_t OFF_WUKV = OFF_WUQ + 2 * SZ_WUQ;
constexpr size_t OFF_WOUTE = OFF_WUKV + 2 * SZ_WUKV;
constexpr size_t OFF_WINO = OFF_WOUTE + 2 * SZ_WOUT;
constexpr size_t OFF_WOUTO = OFF_WINO + 2 * SZ_WINO;
constexpr size_t OFF_WA = OFF_WOUTO + 2 * SZ_WOUT;
constexpr size_t OFF_WX = OFF_WA + SZ_WLRU;
constexpr size_t OFF_MOD = OFF_WX + SZ_WLRU;
constexpr size_t SZ_MOD = (size_t)4 * 5 * 3072 * 4;
constexpr size_t OFF_CX = OFF_MOD + SZ_MOD;
constexpr size_t SZ_CX = (size_t)NB * CTX * D * 4;
constexpr size_t OFF_H = OFF_CX + SZ_CX;
constexpr size_t SZ_H = (size_t)M * D * 2;
constexpr size_t OFF_Z = OFF_H + SZ_H;
constexpr size_t OFF_ZE = OFF_Z;
constexpr size_t SZ_ZE = (size_t)M * 2048 * 2;
constexpr size_t OFF_Q = OFF_ZE + SZ_ZE;
constexpr size_t SZ_Q = (size_t)NB * 8 * TB * 96 * 2;
constexpr size_t OFF_KN = OFF_Q + SZ_Q;
constexpr size_t SZ_KN = (size_t)NB * 8 * TB * 64 * 2;
constexpr size_t OFF_KR = OFF_KN + SZ_KN;
constexpr size_t SZ_KR = (size_t)NB * TB * 32 * 2;
constexpr size_t OFF_VTE = OFF_KR + SZ_KR;
constexpr size_t SZ_VTE = (size_t)NB * 8 * 64 * TB * 2;
constexpr size_t OFF_AGGA = OFF_VTE + SZ_VTE;
constexpr size_t SZ_AGG = (size_t)NB * NCH * 2 * 512 * 4;
constexpr size_t OFF_AGGH = OFF_AGGA + SZ_AGG;
constexpr size_t END_EVEN = OFF_AGGH + SZ_AGG;
constexpr size_t OFF_ZO = OFF_Z;
constexpr size_t SZ_ZO = (size_t)M * 3072 * 2;
constexpr size_t OFF_VTO = OFF_ZO + SZ_ZO;
constexpr size_t SZ_VTO = (size_t)NB * 16 * 64 * TB * 2;
constexpr size_t END_ODD = OFF_VTO + SZ_VTO;
constexpr size_t OFF_BAR = END_EVEN > END_ODD ? END_EVEN : END_ODD;
constexpr size_t OFF_XB = OFF_BAR + 16384;
constexpr size_t WS_NEED = OFF_XB + (size_t)M * D * 2;

struct Params {
  const float *x, *c, *ctx, *c_ctx, *ada_w, *ada_b, *norm_g, *ev_w_in, *q_norm, *w_uq, *kv_norm, *w_ukv;
  const float *conv_w, *conv_b, *wa, *ba, *wx, *bx, *lam, *ev_w_out, *od_w_in, *rpb, *od_w_out, *fin_g;
  float* out;
  char* ws;
};

DI int ltid() { int t = threadIdx.x & 255; asm volatile("" : "+v"(t)); return t; }
DI int lhalf() { return __builtin_amdgcn_readfirstlane((int)(threadIdx.x >> 8)); }
DI int lbid() { const int b = blockIdx.x; int t = (b & 7) + 8 * (2 * (b >> 3) + lhalf()); asm volatile("" : "+s"(t)); return t; }
#define VGRID ((int)(gridDim.x * 2))
DI int pbid() { int t = blockIdx.x; asm volatile("" : "+s"(t)); return t; }
DI unsigned pk2(float a, float b) { fl2_t f = {a, b}; bf2_t r = __builtin_convertvector(f, bf2_t); return __builtin_bit_cast(unsigned, r); }
DI u16 f2bf(float a) { return (u16)(pk2(a, a) & 0xffffu); }
DI float bf2f(u16 v) { return __uint_as_float(((unsigned)v) << 16); }
DI float bflo(unsigned w) { return __uint_as_float(w << 16); }
DI float bfhi(unsigned w) { return __uint_as_float(w & 0xffff0000u); }
DI f32x16 mfma32(bf16x8 a, bf16x8 b, f32x16 c) { return __builtin_amdgcn_mfma_f32_32x32x16_bf16(a, b, c, 0, 0, 0); }
DI int crow(int i, int h) { return (i & 3) + 8 * (i >> 2) + 4 * h; }
DI float silu(float g) { return g * __builtin_amdgcn_rcpf(1.f + __expf(-g)); }
DI float sigmoidf(float g) { return __builtin_amdgcn_rcpf(1.f + __expf(-g)); }
DI float swapmax(float v) { auto rr = __builtin_amdgcn_permlane32_swap(__float_as_uint(v), __float_as_uint(v), false, false);
  return fmaxf(__uint_as_float(rr[0]), __uint_as_float(rr[1])); }
DI float swapsum(float v) { auto rr = __builtin_amdgcn_permlane32_swap(__float_as_uint(v), __float_as_uint(v), false, false);
  return __uint_as_float(rr[0]) + __uint_as_float(rr[1]); }
DI float wave_sum(float v) {
#pragma unroll
  for (int o = 32; o >= 1; o >>= 1) v += __shfl_xor(v, o);
  return v; }
DI bf16x8 pack8(float a0, float a1, float a2, float a3, float a4, float a5, float a6, float a7) {
  uint4 w = {pk2(a0, a1), pk2(a2, a3), pk2(a4, a5), pk2(a6, a7)}; return __builtin_bit_cast(bf16x8, w); }

constexpr int GLD = 72;
template <bool SUMSQ>
DI void gemm_core(const u16* __restrict__ P, int ldp, const u16* __restrict__ Q, int ldq, int K,
                  u16* sP, u16* sQ, f32x16 (&acc)[2][2], float (&ss)[2]) {
  const int tid = ltid(), lane = tid & 63, wid = tid >> 6, r = lane & 31, h = lane >> 5, wm = wid >> 1, wn = wid & 1;
  const int lr = tid >> 3, lc = (tid & 7) * 8;
  uint4 rp0, rp1, rp2, rp3, rq0, rq1, rq2, rq3;
#pragma unroll
  for (int a = 0; a < 2; ++a)
#pragma unroll
    for (int b = 0; b < 2; ++b)
#pragma unroll
      for (int i = 0; i < 16; ++i) acc[a][b][i] = 0.f;
  ss[0] = 0.f; ss[1] = 0.f;
  const u16* Pg = P + (size_t)lr * ldp + lc;
  const u16* Qg = Q + (size_t)lr * ldq + lc;
#define GLOADPQ(KO) do { \
    rp0 = *(const uint4*)(Pg + (KO)); rp1 = *(const uint4*)(Pg + (size_t)32 * ldp + (KO)); \
    rp2 = *(const uint4*)(Pg + (size_t)64 * ldp + (KO)); rp3 = *(const uint4*)(Pg + (size_t)96 * ldp + (KO)); \
    rq0 = *(const uint4*)(Qg + (KO)); rq1 = *(const uint4*)(Qg + (size_t)32 * ldq + (KO)); \
    rq2 = *(const uint4*)(Qg + (size_t)64 * ldq + (KO)); rq3 = *(const uint4*)(Qg + (size_t)96 * ldq + (KO)); } while (0)
  GLOADPQ(0);
  if (lhalf()) __syncthreads();
  for (int k0 = 0; k0 < K; k0 += 64) {
    __syncthreads();
    *(uint4*)(sP + (lr) * GLD + lc) = rp0; *(uint4*)(sP + (lr + 32) * GLD + lc) = rp1;
    *(uint4*)(sP + (lr + 64) * GLD + lc) = rp2; *(uint4*)(sP + (lr + 96) * GLD + lc) = rp3;
    *(uint4*)(sQ + (lr) * GLD + lc) = rq0; *(uint4*)(sQ + (lr + 32) * GLD + lc) = rq1;
    *(uint4*)(sQ + (lr + 64) * GLD + lc) = rq2; *(uint4*)(sQ + (lr + 96) * GLD + lc) = rq3;
    __syncthreads();
    if (k0 + 64 < K) GLOADPQ(k0 + 64);
#pragma unroll
    for (int s = 0; s < 4; ++s) {
      const bf16x8 a0 = *(const bf16x8*)(sP + (wm * 64 + r) * GLD + s * 16 + h * 8);
      const bf16x8 a1 = *(const bf16x8*)(sP + (wm * 64 + 32 + r) * GLD + s * 16 + h * 8);
      const bf16x8 b0 = *(const bf16x8*)(sQ + (wn * 64 + r) * GLD + s * 16 + h * 8);
      const bf16x8 b1 = *(const bf16x8*)(sQ + (wn * 64 + 32 + r) * GLD + s * 16 + h * 8);
      if (SUMSQ) {
#pragma unroll
        for (int j = 0; j < 8; ++j) { float f0 = bf2f((u16)b0[j]), f1 = bf2f((u16)b1[j]); ss[0] += f0 * f0; ss[1] += f1 * f1; }
      }
      acc[0][0] = mfma32(a0, b0, acc[0][0]); acc[0][1] = mfma32(a0, b1, acc[0][1]);
      acc[1][0] = mfma32(a1, b0, acc[1][0]); acc[1][1] = mfma32(a1, b1, acc[1][1]);
    }
  }
  if (!lhalf()) __syncthreads();
}

DI void epi_store_rows(const f32x16 (&acc)[2][2], u16* C, int ldc, int m0, int n0, int nvalid) {
  const int tid = ltid(), lane = tid & 63, wid = tid >> 6, r = lane & 31, h = lane >> 5, wm = wid >> 1, wn = wid & 1;
#pragma unroll
  for (int ni = 0; ni < 2; ++ni) {
    const int nb = n0 + wn * 64 + ni * 32;
    if (nb >= nvalid) continue;
#pragma unroll
    for (int mi = 0; mi < 2; ++mi)
#pragma unroll
      for (int i = 0; i < 16; ++i) {
        const int m = m0 + wm * 64 + mi * 32 + crow(i, h);
        C[(size_t)m * ldc + nb + r] = f2bf(acc[mi][ni][i]);
      }
  }
}
DI void epi_store_vt(const f32x16 (&acc)[2][2], u16* Vt, int nheads, int m0, int nn0) {
  const int tid = ltid(), lane = tid & 63, wid = tid >> 6, r = lane & 31, h = lane >> 5, wm = wid >> 1, wn = wid & 1;
  const int b = m0 / TB, tb0 = m0 % TB;
#pragma unroll
  for (int ni = 0; ni < 2; ++ni) {
    const int nn = nn0 + wn * 64 + ni * 32 + r, hd = nn >> 6, d = nn & 63;
    u16* base = Vt + ((size_t)(b * nheads + hd) * 64 + d) * TB + tb0 + wm * 64 + 4 * h;
#pragma unroll
    for (int mi = 0; mi < 2; ++mi)
#pragma unroll
      for (int g = 0; g < 4; ++g) {
        uint2 w = {pk2(acc[mi][ni][4 * g], acc[mi][ni][4 * g + 1]), pk2(acc[mi][ni][4 * g + 2], acc[mi][ni][4 * g + 3])};
        *(uint2*)(base + mi * 32 + 8 * g) = w;
      }
  }
}

DI void prep_tile(const float* __restrict__ src, int lds_, int nsrc, int k0, int n0, u16* __restrict__ dst, int K, int dn0,
                  const float* __restrict__ rowscale, float cscale, float* sT) {
  const int tid = ltid();
#pragma unroll
  for (int i = 0; i < 4; ++i) {
    const int idx = tid + 256 * i, kk = idx >> 4, n4 = (idx & 15) * 4;
    const bool ok = n0 + n4 < nsrc;
    float4 v = *(const float4*)(src + (size_t)(k0 + kk) * lds_ + (ok ? n0 + n4 : 0));
    if (!ok) v = make_float4(0.f, 0.f, 0.f, 0.f);
    const float sc = cscale * (rowscale ? rowscale[k0 + kk] : 1.f);
    sT[(n4 + 0) * 65 + kk] = v.x * sc; sT[(n4 + 1) * 65 + kk] = v.y * sc; sT[(n4 + 2) * 65 + kk] = v.z * sc; sT[(n4 + 3) * 65 + kk] = v.w * sc;
  }
  __syncthreads();
#pragma unroll
  for (int i = 0; i < 2; ++i) {
    const int idx = tid + 256 * i, n = idx >> 3, c = (idx & 7) * 8;
    const float* s = sT + n * 65 + c;
    uint4 w = {pk2(s[0], s[1]), pk2(s[2], s[3]), pk2(s[4], s[5]), pk2(s[6], s[7])};
    *(uint4*)(dst + (size_t)(dn0 + n) * K + k0 + c) = w;
  }
  __syncthreads();
}

DI void phase_prep(const Params& p, char* smem) {
  const int tid = ltid(), lane = tid & 63, wid = tid >> 6;
  constexpr int NADA = 192, PER_I = 512 + 48 + 32 + 256 + 1024 + 256, NTOT = NADA + 2 * PER_I + 64;
  for (int it = lbid(); it < NTOT; it += VGRID) {
    if (it < NADA) {
      const int layer = it / 48, j = (it % 48) * 64 + lane;
      float* sCond = (float*)smem;
      float* sRed = sCond + 5 * 1024;
      for (int e = tid; e < 5 * 1024; e += 256) { const float v = e < 4096 ? p.c[e] : p.c_ctx[e - 4096]; sCond[e] = silu(v); }
      __syncthreads();
      float a0 = 0.f, a1 = 0.f, a2 = 0.f, a3 = 0.f, a4 = 0.f;
      const float* w = p.ada_w + ((size_t)layer * 1024 + wid * 256) * 3072 + j;
      const float* sc = sCond + wid * 256;
#pragma unroll 8
      for (int k = 0; k < 256; ++k) {
        const float wv = w[(size_t)k * 3072];
        a0 += sc[k] * wv; a1 += sc[1024 + k] * wv; a2 += sc[2048 + k] * wv; a3 += sc[3072 + k] * wv; a4 += sc[4096 + k] * wv;
      }
      sRed[(wid * 5 + 0) * 64 + lane] = a0; sRed[(wid * 5 + 1) * 64 + lane] = a1; sRed[(wid * 5 + 2) * 64 + lane] = a2;
      sRed[(wid * 5 + 3) * 64 + lane] = a3; sRed[(wid * 5 + 4) * 64 + lane] = a4;
      __syncthreads();
      if (tid < 64) {
        float* mod = (float*)(p.ws + OFF_MOD);
        const float bias = p.ada_b[layer * 3072 + j];
#pragma unroll
        for (int rw = 0; rw < 5; ++rw) {
          const float s = sRed[(0 * 5 + rw) * 64 + lane] + sRed[(1 * 5 + rw) * 64 + lane] + sRed[(2 * 5 + rw) * 64 + lane] + sRed[(3 * 5 + rw) * 64 + lane];
          mod[((size_t)layer * 5 + rw) * 3072 + j] = s + bias;
        }
      }
      __syncthreads();
      continue;
    }
    int q = it - NADA;
    float* sT = (float*)smem;
    if (q < 2 * PER_I) {
      const int i = q / PER_I; q -= i * PER_I;
      if (q < 512) {
        const int kt = q & 15, nt = q >> 4;
        prep_tile(p.ev_w_in + (size_t)i * 1024 * 1952, 1952, 1952, kt * 64, nt * 64, (u16*)(p.ws + OFF_WINE + i * SZ_WINE), 1024, nt * 64, nullptr, 1.f, sT);
      } else if (q < 560) {
        q -= 512; const int kt = q & 3, nt = q >> 2;
        prep_tile(p.w_uq + (size_t)i * 256 * 768, 768, 768, kt * 64, nt * 64, (u16*)(p.ws + OFF_WUQ + i * SZ_WUQ), 256, nt * 64, p.q_norm + i * 256, 1.f, sT);
      } else if (q < 592) {
        q -= 560; const int kt = q & 1, nt = q >> 1;
        prep_tile(p.w_ukv + (size_t)i * 128 * 1024, 1024, 1024, kt * 64, nt * 64, (u16*)(p.ws + OFF_WUKV + i * SZ_WUKV), 128, nt * 64, p.kv_norm + i * 128, 1.f, sT);
      } else if (q < 848) {
        q -= 592; const int kt = q & 15, nt = q >> 4;
        prep_tile(p.ev_w_out + (size_t)i * 1024 * 1024, 1024, 1024, kt * 64, nt * 64, (u16*)(p.ws + OFF_WOUTE + i * SZ_WOUT), 1024, nt * 64, nullptr, 1.f, sT);
      } else if (q < 1872) {
        q -= 848; const int kt = q & 15, nt = q >> 4;
        const int n0 = nt * 64, reg = n0 >> 10;
        const int dn0 = (reg == 2 ? 3072 : reg == 3 ? 2048 : reg * 1024) + (n0 & 1023);
        prep_tile(p.od_w_in + (size_t)i * 1024 * 4096, 4096, 4096, kt * 64, n0, (u16*)(p.ws + OFF_WINO + i * SZ_WINO), 1024, dn0, nullptr, reg == 0 ? 0.125f * LOG2E : 1.f, sT);
      } else {
        q -= 1872; const int kt = q & 15, nt = q >> 4;
        prep_tile(p.od_w_out + (size_t)i * 1024 * 1024, 1024, 1024, kt * 64, nt * 64, (u16*)(p.ws + OFF_WOUTO + i * SZ_WOUT), 1024, nt * 64, nullptr, 1.f, sT);
      }
    } else {
      q -= 2 * PER_I;
      if (q < 32) prep_tile(p.wa + (size_t)q * 4096, 64, 64, 0, 0, (u16*)(p.ws + OFF_WA) + (size_t)q * 4096, 64, 0, nullptr, 1.f, sT);
      else { q -= 32; prep_tile(p.wx + (size_t)q * 4096, 64, 64, 0, 0, (u16*)(p.ws + OFF_WX) + (size_t)q * 4096, 64, 0, nullptr, 1.f, sT); }
    }
  }
}

DI const float* resid_in(const Params& p, int L, int b, int t) {
  if (t < CTX) return (L == 0 ? p.ctx : (const float*)(p.ws + OFF_CX)) + ((size_t)b * CTX + t) * D;
  return (L == 0 ? p.x : (const float*)p.out) + ((size_t)b * SEQ + (t - CTX)) * D;
}
DI float* resid_out(const Params& p, int b, int t) {
  if (t < CTX) return (float*)(p.ws + OFF_CX) + ((size_t)b * CTX + t) * D;
  return p.out + ((size_t)b * SEQ + (t - CTX)) * D;
}

DI void phase_norm(const Params& p, int L) {
  const int tid = ltid(), lane = tid & 63, wid = tid >> 6;
  const float* mod = (const float*)(p.ws + OFF_MOD);
  u16* hbuf = (u16*)(p.ws + OFF_H);
  for (int it = lbid(); it < M / 4; it += VGRID) {
    const int m = it * 4 + wid, b = m / TB, t = m % TB, mrow = t < CTX ? 4 : b;
    float4 v[4]; float ssq = 0.f;
    if (L == 0) {
      const float4* src = (const float4*)resid_in(p, 0, b, t);
#pragma unroll
      for (int j = 0; j < 4; ++j) v[j] = src[lane + 64 * j];
    } else {
      const uint2* src = (const uint2*)((const u16*)(p.ws + OFF_XB) + (size_t)m * 1024);
#pragma unroll
      for (int j = 0; j < 4; ++j) { const uint2 w = src[lane + 64 * j]; v[j] = make_float4(bflo(w.x), bfhi(w.x), bflo(w.y), bfhi(w.y)); }
    }
#pragma unroll
    for (int j = 0; j < 4; ++j) ssq += v[j].x * v[j].x + v[j].y * v[j].y + v[j].z * v[j].z + v[j].w * v[j].w;
    ssq = wave_sum(ssq);
    const float rs = rsqrtf(ssq * (1.f / 1024.f) + RMS_EPS);
    const float4* g4 = (const float4*)(p.norm_g + L * 1024);
    const float4* sh4 = (const float4*)(mod + ((size_t)L * 5 + mrow) * 3072);
    const float4* sc4 = sh4 + 256;
#pragma unroll
    for (int j = 0; j < 4; ++j) {
      const int k4 = lane + 64 * j;
      const float4 g = g4[k4], sh = sh4[k4], sc = sc4[k4];
      const float y0 = v[j].x * rs * g.x * (1.f + sc.x) + sh.x, y1 = v[j].y * rs * g.y * (1.f + sc.y) + sh.y;
      const float y2 = v[j].z * rs * g.z * (1.f + sc.z) + sh.z, y3 = v[j].w * rs * g.w * (1.f + sc.w) + sh.w;
      uint2 w = {pk2(y0, y1), pk2(y2, y3)};
      *(uint2*)(hbuf + (size_t)m * 1024 + k4 * 4) = w;
    }
  }
}

DI void phase_final_norm(const Params& p) {
  const int tid = ltid(), lane = tid & 63, wid = tid >> 6;
  for (int it = lbid(); it < NB * SEQ / 4; it += VGRID) {
    const int m = it * 4 + wid;
    float4* row = (float4*)(p.out + (size_t)m * 1024);
    float4 v[4]; float ssq = 0.f;
#pragma unroll
    for (int j = 0; j < 4; ++j) { v[j] = row[lane + 64 * j]; ssq += v[j].x * v[j].x + v[j].y * v[j].y + v[j].z * v[j].z + v[j].w * v[j].w; }
    ssq = wave_sum(ssq);
    const float rs = rsqrtf(ssq * (1.f / 1024.f) + RMS_EPS);
    const float4* g4 = (const float4*)p.fin_g;
#pragma unroll
    for (int j = 0; j < 4; ++j) {
      const float4 g = g4[lane + 64 * j];
      row[lane + 64 * j] = make_float4(v[j].x * rs * g.x, v[j].y * rs * g.y, v[j].z * rs * g.z, v[j].w * rs * g.w);
    }
  }
}

DI void phase_win_even(const Params& p, int li, char* smem) {
  u16* sP = (u16*)smem; u16* sQ = sP + 128 * GLD;
  const u16* A = (const u16*)(p.ws + OFF_H);
  const u16* W = (const u16*)(p.ws + OFF_WINE + li * SZ_WINE);
  u16* Z = (u16*)(p.ws + OFF_ZE);
  for (int it = lbid(); it < (M / 128) * 16; it += VGRID) {
    const int mt = it >> 4, nt = it & 15;
    f32x16 acc[2][2]; float ss[2];
    gemm_core<false>(A + (size_t)mt * 128 * 1024, 1024, W + (size_t)nt * 128 * 1024, 1024, 1024, sP, sQ, acc, ss);
    epi_store_rows(acc, Z, 2048, mt * 128, nt * 128, 1952);
  }
}
DI void phase_win_odd(const Params& p, int li, char* smem) {
  u16* sP = (u16*)smem; u16* sQ = sP + 128 * GLD;
  const u16* A = (const u16*)(p.ws + OFF_H);
  const u16* W = (const u16*)(p.ws + OFF_WINO + li * SZ_WINO);
  u16* Z = (u16*)(p.ws + OFF_ZO);
  u16* Vt = (u16*)(p.ws + OFF_VTO);
  for (int it = lbid(); it < (M / 128) * 32; it += VGRID) {
    const int mt = it >> 5, nt = it & 31;
    f32x16 acc[2][2]; float ss[2];
    gemm_core<false>(A + (size_t)mt * 128 * 1024, 1024, W + (size_t)nt * 128 * 1024, 1024, 1024, sP, sQ, acc, ss);
    if (nt < 24) epi_store_rows(acc, Z, 3072, mt * 128, nt * 128, 3072);
    else epi_store_vt(acc, Vt, 16, mt * 128, nt * 128 - 3072);
  }
}

DI void phase_out(const Params& p, int L, char* smem, bool dry = false) {
  u16* sP = (u16*)smem; u16* sQ = sP + 128 * GLD;
  const int li = L >> 1;
  const u16* A = (const u16*)(p.ws + OFF_H);
  const u16* W = (const u16*)(p.ws + ((L & 1) ? OFF_WOUTO : OFF_WOUTE) + li * SZ_WOUT);
  const float* mod = (const float*)(p.ws + OFF_MOD);
  const int tid = ltid(), lane = tid & 63, wid = tid >> 6, r = lane & 31, h = lane >> 5, wm = wid >> 1, wn = wid & 1;
  for (int it = lbid(); it < (M / 128) * 8; it += VGRID) {
    const int mt = it >> 3, nt = it & 7;
    const int m0 = mt * 128, b = m0 / TB, tb0 = m0 % TB;
    const bool isctx = tb0 < CTX;
    if (isctx && L == 3) continue;
    f32x16 acc[2][2]; float ss[2];
    gemm_core<false>(A + (size_t)m0 * 1024, 1024, W + (size_t)nt * 128 * 1024, 1024, 1024, sP, sQ, acc, ss);
    const float* rin32 = resid_in(p, 0, b, tb0);
    u16* xb = (u16*)(p.ws + (dry ? OFF_Z : OFF_XB)) + (size_t)m0 * 1024;
    const u16* xin = (const u16*)(p.ws + OFF_XB) + (size_t)m0 * 1024;
    float* rout32 = p.out + ((size_t)b * SEQ + (tb0 - CTX)) * D;
    const float* gate = mod + ((size_t)L * 5 + (isctx ? 4 : b)) * 3072 + 2048;
#pragma unroll
    for (int ni = 0; ni < 2; ++ni) {
      const int n = nt * 128 + wn * 64 + ni * 32 + r;
      const float gt = gate[n];
#pragma unroll
      for (int mi = 0; mi < 2; ++mi)
#pragma unroll
        for (int i = 0; i < 16; ++i) {
          const size_t o = (size_t)(wm * 64 + mi * 32 + crow(i, h)) * 1024 + n;
          const float xv = L == 0 ? rin32[o] : bf2f(xin[o]);
          const float y = xv + gt * acc[mi][ni][i];
          if (L == 3 && !dry) rout32[o] = y; else xb[o] = f2bf(y);
        }
    }
  }
}

DI void qproj_tile(const Params& p, int li, int mt, int nt, char* smem) {
  u16* sP = (u16*)smem; u16* sQ = sP + 128 * GLD;
  const int tid = ltid(), lane = tid & 63, wid = tid >> 6, r = lane & 31, h = lane >> 5, wm = wid >> 1, wn = wid & 1;
  const u16* W = (const u16*)(p.ws + OFF_WUQ + li * SZ_WUQ);
  const u16* Z = (const u16*)(p.ws + OFF_ZE);
  u16* Qb = (u16*)(p.ws + OFF_Q);
  f32x16 acc[2][2]; float ss[2];
  gemm_core<true>(W + (size_t)nt * 128 * 256, 256, Z + (size_t)mt * 128 * 2048, 2048, 256, sP, sQ, acc, ss);
#pragma unroll
  for (int ni = 0; ni < 2; ++ni) {
    const float rs = rsqrtf(swapsum(ss[ni]) * (1.f / 256.f) + RMS_EPS);
    const int m = mt * 128 + wn * 64 + ni * 32 + r, b = m / TB, t = m % TB;
    const int pos = t - CTX;
    const float prow = (float)(pos >> 6), pcol = (float)(pos & 63);
#pragma unroll
    for (int mi = 0; mi < 2; ++mi) {
      const int gt = (nt * 128 + wm * 64 + mi * 32) >> 5, hd = gt / 3, part = gt % 3;
      float v[16];
#pragma unroll
      for (int i = 0; i < 16; ++i) v[i] = acc[mi][ni][i] * rs;
      if (part == 2 && t >= CTX) {
#pragma unroll
        for (int i = 0; i < 4; ++i) {
          const float inv = exp2f(-(float)(4 * h + i) * 1.6609640474436813f);
          float ar = prow * inv, ac = pcol * inv;
          const float cr = __cosf(ar), sr = __sinf(ar), cc = __cosf(ac), sc = __sinf(ac);
          const float x1 = v[i], x2 = v[i + 4], y1 = v[8 + i], y2 = v[12 + i];
          v[i] = x1 * cr - x2 * sr; v[i + 4] = x2 * cr + x1 * sr;
          v[8 + i] = y1 * cc - y2 * sc; v[12 + i] = y2 * cc + y1 * sc;
        }
      }
      u16* dst = Qb + ((size_t)(b * 8 + hd) * TB + t) * 96 + part * 32 + 4 * h;
#pragma unroll
      for (int g = 0; g < 4; ++g) {
        uint2 w = {pk2(v[4 * g] * MLA_QS, v[4 * g + 1] * MLA_QS), pk2(v[4 * g + 2] * MLA_QS, v[4 * g + 3] * MLA_QS)};
        *(uint2*)(dst + 8 * g) = w;
      }
    }
  }
}
DI void kvproj_tile(const Params& p, int li, int mt, int nt, char* smem) {
  u16* sP = (u16*)smem; u16* sQ = sP + 128 * GLD;
  const int tid = ltid(), lane = tid & 63, wid = tid >> 6, r = lane & 31, h = lane >> 5, wm = wid >> 1, wn = wid & 1;
  const u16* W = (const u16*)(p.ws + OFF_WUKV + li * SZ_WUKV);
  const u16* Z = (const u16*)(p.ws + OFF_ZE);
  u16* Kn = (u16*)(p.ws + OFF_KN);
  u16* Vt = (u16*)(p.ws + OFF_VTE);
  f32x16 acc[2][2]; float ss[2];
  gemm_core<true>(W + (size_t)nt * 128 * 128, 128, Z + (size_t)mt * 128 * 2048 + 256, 2048, 128, sP, sQ, acc, ss);
#pragma unroll
  for (int ni = 0; ni < 2; ++ni) {
    const float rs = rsqrtf(swapsum(ss[ni]) * (1.f / 128.f) + RMS_EPS);
    const int m = mt * 128 + wn * 64 + ni * 32 + r, b = m / TB, t = m % TB;
#pragma unroll
    for (int mi = 0; mi < 2; ++mi) {
      const int gt = (nt * 128 + wm * 64 + mi * 32) >> 5, hd = gt >> 2, part = gt & 3;
      if (part < 2) {
        u16* dst = Kn + ((size_t)(b * 8 + hd) * TB + t) * 64 + part * 32 + 4 * h;
#pragma unroll
        for (int g = 0; g < 4; ++g) {
          uint2 w = {pk2(acc[mi][ni][4 * g] * rs, acc[mi][ni][4 * g + 1] * rs), pk2(acc[mi][ni][4 * g + 2] * rs, acc[mi][ni][4 * g + 3] * rs)};
          *(uint2*)(dst + 8 * g) = w;
        }
      } else {
        u16* dst = Vt + ((size_t)(b * 8 + hd) * 64 + (part - 2) * 32) * TB + t;
#pragma unroll
        for (int i = 0; i < 16; ++i) dst[(size_t)crow(i, h) * TB] = f2bf(acc[mi][ni][i] * rs);
      }
    }
  }
}
DI void krope_item(const Params& p, int it) {
  const int tid = ltid();
  const int m = it * 16 + (tid >> 4), f = tid & 15, blk = f >> 3, fi = f & 7;
  const int t = m % TB;
  const u16* src = (const u16*)(p.ws + OFF_ZE) + (size_t)m * 2048 + 384 + 16 * blk + fi;
  u16* dst = (u16*)(p.ws + OFF_KR) + (size_t)m * 32 + 16 * blk + fi;
  float x1 = bf2f(src[0]), x2 = bf2f(src[8]);
  if (t >= CTX) {
    const int pos = t - CTX;
    const float ang = (float)(blk ? (pos & 63) : (pos >> 6)) * exp2f(-(float)fi * 1.6609640474436813f);
    const float c = __cosf(ang), s = __sinf(ang);
    const float y1 = x1 * c - x2 * s, y2 = x2 * c + x1 * s;
    x1 = y1; x2 = y2;
  }
  dst[0] = f2bf(x1); dst[8] = f2bf(x2);
}

constexpr int LRU_SU = 0, LRU_SA = 64 * 72 * 2, LRU_SUU = LRU_SA + 2 * 64 * 64 * 4, LRU_SMEM = LRU_SUU + 2 * 64 * 64 * 2;
template <int PASS>
DI void lru_item(const Params& p, int li, int it, char* smem) {
  const int tid = ltid(), lane = tid & 63, wid = tid >> 6, r = lane & 31, h = lane >> 5;
  const int n = it & 7, j = (it >> 3) % NCH, b = it / (8 * NCH);
  const int t0 = j * 64, seg_lo = j < 4 ? 0 : CTX, seg_hi = j < 4 ? CTX : TB;
  u16* sU = (u16*)(smem + LRU_SU);
  float* sA = (float*)(smem + LRU_SA);
  u16* sUU = (u16*)(smem + LRU_SUU);
  const u16* zE = (const u16*)(p.ws + OFF_ZE);
  const int mi = wid >> 1, ni = wid & 1;
  const int cc = ni * 32 + r, gcw = n * 64 + cc;
  const int cconv = tid & 63, tg = tid >> 6, gcc = n * 64 + cconv;
  const u16* zcol = zE + (size_t)b * TB * 2048 + 928 + gcc;
  const int tb = t0 + tg * 16;
  float xv[19];
#pragma unroll
  for (int q = 0; q < 19; ++q) {
    const int t = tb - 2 + q; const bool ok = (t >= seg_lo) && (t < seg_hi);
    const float v = bf2f(zcol[(size_t)(ok ? t : seg_lo) * 2048]);
    xv[q] = ok ? v : 0.f;
  }
  const float* cw = p.conv_w + (size_t)li * 4 * 512 + gcc;
  const float w0 = cw[0], w1 = cw[512], w2 = cw[1024], w3 = cw[1536], cb = p.conv_b[li * 512 + gcc];
  const u16* WA = (const u16*)(p.ws + OFF_WA) + ((size_t)(li * 2) * 8 + n) * 4096 + (ni * 32 + r) * 64 + 8 * h;
  const u16* WX = (const u16*)(p.ws + OFF_WX) + ((size_t)(li * 2) * 8 + n) * 4096 + (ni * 32 + r) * 64 + 8 * h;
  bf16x8 wfa[2][4], wfx[2][4];
#pragma unroll
  for (int d = 0; d < 2; ++d)
#pragma unroll
    for (int s = 0; s < 4; ++s) { wfa[d][s] = *(const bf16x8*)(WA + (size_t)d * 8 * 4096 + 16 * s); wfx[d][s] = *(const bf16x8*)(WX + (size_t)d * 8 * 4096 + 16 * s); }
  float pba[2], pbx[2], plam[2];
#pragma unroll
  for (int d = 0; d < 2; ++d) { const int pi = (li * 2 + d) * 512 + gcw; pba[d] = p.ba[pi]; pbx[d] = p.bx[pi]; plam[d] = p.lam[pi]; }
  float* aggA = (float*)(p.ws + OFF_AGGA);
  float* aggH = (float*)(p.ws + OFF_AGGH);
  const int dsc = (tid >> 6) & 1, csc = tid & 63;
  const size_t osc = ((size_t)(b * NCH + j) * 2 + dsc) * 512 + n * 64 + csc;
  float carry = 0.f; u16 gq[16];
  if (PASS == 3) {
    carry = aggH[osc];
#pragma unroll
    for (int i = 0; i < 16; ++i) { const int idx = tid + 256 * i, t = idx >> 6, c = idx & 63; gq[i] = zE[((size_t)b * TB + t0 + t) * 2048 + 1440 + n * 64 + c]; }
  }
  {
#pragma unroll
    for (int tt = 0; tt < 16; ++tt) {
      const float u = w0 * xv[tt] + w1 * xv[tt + 1] + w2 * xv[tt + 2] + w3 * xv[tt + 3] + cb;
      sU[(tg * 16 + tt) * 72 + cconv] = f2bf(u);
    }
  }
  __syncthreads();
  {
    f32x16 acc[2][2];
#pragma unroll
    for (int d = 0; d < 2; ++d)
#pragma unroll
      for (int q = 0; q < 2; ++q)
#pragma unroll
        for (int i = 0; i < 16; ++i) acc[d][q][i] = 0.f;
#pragma unroll
    for (int s = 0; s < 4; ++s) {
      const bf16x8 af = *(const bf16x8*)(sU + (mi * 32 + r) * 72 + 16 * s + 8 * h);
#pragma unroll
      for (int d = 0; d < 2; ++d) { acc[d][0] = mfma32(af, wfa[d][s], acc[d][0]); acc[d][1] = mfma32(af, wfx[d][s], acc[d][1]); }
    }
#pragma unroll
    for (int d = 0; d < 2; ++d) {
      const float ba = pba[d], bx = pbx[d], lam = plam[d];
      const float sp = log1pf(__expf(-lam));
#pragma unroll
      for (int i = 0; i < 16; ++i) {
        const int tl = mi * 32 + crow(i, h);
        const float rr = sigmoidf(acc[d][0][i] + ba), ii = sigmoidf(acc[d][1][i] + bx);
        const float la = -8.f * rr * sp;
        const float a = __expf(la);
        const float x2 = 2.f * la;
        const float ser = -x2 * (1.f + x2 * (0.5f + x2 * (0.16666667f + x2 * (0.041666668f + x2 * (0.0083333338f + x2 * 0.0013888889f)))));
        const float om = x2 > -0.25f ? ser : 1.f - a * a;
        const float mult = __builtin_amdgcn_sqrtf(fmaxf(om, 0.f));
        const float uval = bf2f(sU[tl * 72 + cc]);
        sA[(d * 64 + tl) * 64 + cc] = a;
        sUU[(d * 64 + tl) * 64 + cc] = f2bf(mult * ii * uval);
      }
    }
  }
  __syncthreads();
  if (tid < 128) {
    const int d = tid >> 6, c = tid & 63, gc = n * 64 + c;
    const int tf = d ? 63 : 0, ts = d ? -64 : 64;
    float* pa = sA + (d * 64 + tf) * 64 + c;
    const u16* pu = sUU + (d * 64 + tf) * 64 + c;
    const size_t o = ((size_t)(b * NCH + j) * 2 + d) * 512 + gc;
    float hh = PASS == 1 ? 0.f : carry;
    float A = 1.f;
#pragma unroll
    for (int blk = 0; blk < 2; ++blk) {
      float av[32], uv[32];
#pragma unroll
      for (int k = 0; k < 32; ++k) { av[k] = pa[(blk * 32 + k) * ts]; uv[k] = bf2f(pu[(blk * 32 + k) * ts]); }
#pragma unroll
      for (int k = 0; k < 32; ++k) { A *= av[k]; hh = av[k] * hh + uv[k]; av[k] = hh; }
      if (PASS == 3) {
#pragma unroll
        for (int k = 0; k < 32; ++k) pa[(blk * 32 + k) * ts] = av[k];
      }
    }
    if (PASS == 1) { aggA[o] = A; aggH[o] = hh; }
  }
  if (PASS == 3) {
    __syncthreads();
    u16* mix = (u16*)(p.ws + OFF_H);
#pragma unroll
    for (int i = 0; i < 16; ++i) {
      const int idx = tid + 256 * i, t = idx >> 6, c = idx & 63, gc = n * 64 + c;
      const float rsum = sA[t * 64 + c] + sA[(64 + t) * 64 + c];
      const size_t m = (size_t)b * TB + t0 + t;
      const float g = bf2f(gq[i]);
      mix[m * 1024 + 512 + gc] = f2bf(rsum * silu(g));
    }
  }
  __syncthreads();
}

DI void phase_e2(const Params& p, int li, char* smem) {
  constexpr int N_LRU = NB * NCH * 8, N_Q = (M / 128) * 6, N_KV = (M / 128) * 8, N_KR = M / 16;
  for (int it = lbid(); it < N_LRU + N_Q + N_KV + N_KR; it += VGRID) {
    int q = it;
    if (q < N_LRU) { lru_item<1>(p, li, q, smem); continue; }
    q -= N_LRU;
    if (q < N_Q) { qproj_tile(p, li, q / 6, q % 6, smem); continue; }
    q -= N_Q;
    if (q < N_KV) { kvproj_tile(p, li, q >> 3, q & 7, smem); continue; }
    q -= N_KV;
    krope_item(p, q);
  }
}

template <int MODE>
DI void attn_item(const Params& p, int li, int it, char* smem) {
  constexpr int DQK = MODE == 0 ? 96 : 64, KLD = DQK + 8, KS = DQK / 16, VLD = 68;
  constexpr int SK_E = 64 * KLD, SV_E = 64 * VLD;
  u16* sK = (u16*)smem;
  u16* sV = sK + 2 * SK_E;
  float* sBias = (float*)(sV + 2 * SV_E);
  const int tid = ltid(), lane = tid & 63, wid = tid >> 6, r = lane & 31, h = lane >> 5;

  int b, hd, bh, tq, nsteps;
  int qrow = 0, qcol = 0, rsA = 0, rsW = 0;
  const u16* Qp;
  if (MODE == 0) {
    int qb;
    if (it < 2048) { const int ch = it >> 9, w = it & 511; bh = ch * 8 + (w & 7); qb = w >> 3; }
    else { const int jx = it - 2048; bh = jx >> 1; qb = 64 + (jx & 1); }
    b = bh >> 3; hd = bh & 7;
    int tqb;
    if (qb < 64) { tqb = CTX + qb * 128; nsteps = NCH; } else { tqb = (qb - 64) * 128; nsteps = CTX / 64; }
    tq = tqb + wid * 32 + r;
    Qp = (const u16*)(p.ws + OFF_Q) + ((size_t)bh * TB + tq) * 96 + 8 * h;
  } else {
    if (it < 4096) {
      const int ch = it >> 9, w = it & 511;
      bh = ch * 8 + (w & 7); const int rp = w >> 3;
      const int r0 = 2 * rp;
      qrow = r0 + (wid >> 1); qcol = (wid & 1) * 32 + r;
      tq = CTX + qrow * 64 + qcol;
      rsA = min(max(r0 - 4, 0), 120);
      const int rsB = min(max(r0 - 3, 0), 120);
      rsW = (wid >> 1) ? rsB : rsA;
      nsteps = 4 + rsB + 8 - rsA;
    } else {
      const int jx = it - 4096;
      bh = jx >> 1; tq = (jx & 1) * 128 + wid * 32 + r; nsteps = 4;
    }
    b = bh >> 4; hd = bh & 15;
    Qp = (const u16*)(p.ws + OFF_ZO) + ((size_t)b * TB + tq) * 3072 + hd * 64 + 8 * h;
    const float* rpb = p.rpb + ((size_t)li * 16 + hd) * 465;
    for (int e = tid; e < 576; e += 256) { const int k = e - 48; sBias[e] = (k >= 0 && k < 465) ? rpb[k] * LOG2E : 0.f; }
  }
  bf16x8 qf[KS];
#pragma unroll
  for (int s = 0; s < KS; ++s) qf[s] = *(const bf16x8*)(Qp + 16 * s);

  const int lkey = tid >> 3, lc8 = (tid & 7) * 8;
  const int rkey = tid >> 2, rc8 = (tid & 3) * 8;
  uint4 aK0, aK1, aV0, aV1, aR, bK0, bK1, bV0, bV1, bR;
  const u16 *gK, *gV, *gR = nullptr;
  size_t kstride;
  if (MODE == 0) {
    gK = (const u16*)(p.ws + OFF_KN) + ((size_t)bh * TB + lkey) * 64 + lc8; kstride = 64;
    gR = (const u16*)(p.ws + OFF_KR) + ((size_t)b * TB + rkey) * 32 + rc8;
    gV = (const u16*)(p.ws + OFF_VTE) + ((size_t)bh * 64 + lkey) * TB + lc8;
  } else {
    gK = (const u16*)(p.ws + OFF_ZO) + ((size_t)b * TB + lkey) * 3072 + 1024 + hd * 64 + lc8; kstride = 3072;
    gV = (const u16*)(p.ws + OFF_VTO) + ((size_t)bh * 64 + lkey) * TB + lc8;
  }
  auto tile_t0 = [&](int st) -> int { if (MODE == 0) return st * 64; return st < 4 ? st * 64 : CTX + (rsA + st - 4) * 64; };
#define ATT_LOAD(X, st_) do { const int t0_ = tile_t0(st_); \
    X##K0 = *(const uint4*)(gK + (size_t)t0_ * kstride); X##K1 = *(const uint4*)(gK + (size_t)(t0_ + 32) * kstride); \
    if (MODE == 0) X##R = *(const uint4*)(gR + (size_t)t0_ * 32); \
    X##V0 = *(const uint4*)(gV + t0_); X##V1 = *(const uint4*)(gV + (size_t)32 * TB + t0_); } while (0)
#define ATT_STORE(X, sKb_, sVb_) do { \
    *(uint4*)((sKb_) + lkey * KLD + lc8) = X##K0; *(uint4*)((sKb_) + (lkey + 32) * KLD + lc8) = X##K1; \
    if (MODE == 0) *(uint4*)((sKb_) + rkey * KLD + 64 + rc8) = X##R; \
    *(uint2*)((sVb_) + lkey * VLD + lc8) = make_uint2(X##V0.x, X##V0.y); *(uint2*)((sVb_) + lkey * VLD + lc8 + 4) = make_uint2(X##V0.z, X##V0.w); \
    *(uint2*)((sVb_) + (lkey + 32) * VLD + lc8) = make_uint2(X##V1.x, X##V1.y); *(uint2*)((sVb_) + (lkey + 32) * VLD + lc8 + 4) = make_uint2(X##V1.z, X##V1.w); } while (0)
  f32x16 O0, O1;
#pragma unroll
  for (int i = 0; i < 16; ++i) { O0[i] = 0.f; O1[i] = 0.f; }
  float m_run = 0.f, l_run = 0.f;
  f32x16 NEGM;
#pragma unroll
  for (int i = 0; i < 16; ++i) NEGM[i] = 0.f;
  constexpr float THR = 8.f;
  auto compute = [&](const u16* sKb, const u16* sVb, int st) {
    bool active = st < nsteps;
    int krow = 0;
    if (MODE == 1 && st >= 4) { krow = rsA + st - 4; active = active && (krow >= rsW) && (krow < rsW + 8); }
    if (!active) return;
    f32x16 S0 = NEGM, S1 = NEGM;
    bf16x8 kfa[KS], kfb[KS];
#pragma unroll
    for (int s = 0; s < KS; ++s) {
      kfa[s] = *(const bf16x8*)(sKb + r * KLD + 16 * s + 8 * h);
      kfb[s] = *(const bf16x8*)(sKb + (32 + r) * KLD + 16 * s + 8 * h);
    }
#pragma unroll
    for (int s = 0; s < KS; ++s) { S0 = mfma32(kfa[s], qf[s], S0); S1 = mfma32(kfb[s], qf[s], S1); }
    const bool local = MODE == 1 && st >= 4;
    const int qt = qcol >> 5;
    if (local) {
      const int dr = krow - qrow + 7;
      const int cs = min(max(qcol - 8, 0), 48);
      const float* tb = sBias + 48 + dr * 31 - qcol + 15;
      if (qt == 0) {
#pragma unroll
        for (int i = 0; i < 16; ++i) { const int kc = crow(i, h); S0[i] = (unsigned)(kc - cs) < 16u ? S0[i] + tb[kc] : -1e30f; }
#pragma unroll
        for (int i = 0; i < 4; ++i) { const int kc = 32 + crow(i, h); S1[i] = (unsigned)(kc - cs) < 16u ? S1[i] + tb[kc] : -1e30f; }
#pragma unroll
        for (int i = 4; i < 16; ++i) S1[i] = -1e30f;
      } else {
#pragma unroll
        for (int i = 0; i < 12; ++i) S0[i] = -1e30f;
#pragma unroll
        for (int i = 12; i < 16; ++i) { const int kc = crow(i, h); S0[i] = (unsigned)(kc - cs) < 16u ? S0[i] + tb[kc] : -1e30f; }
#pragma unroll
        for (int i = 0; i < 16; ++i) { const int kc = 32 + crow(i, h); S1[i] = (unsigned)(kc - cs) < 16u ? S1[i] + tb[kc] : -1e30f; }
      }
    }
    bool ex = false;
#pragma unroll
    for (int i = 0; i < 16; ++i) ex |= (S0[i] > THR) | (S1[i] > THR);
    if (__any(ex) || st == 0) {
      float pm = fmaxf(S0[0], S1[0]);
#pragma unroll
      for (int i = 1; i < 16; ++i) pm = fmaxf(pm, fmaxf(S0[i], S1[i]));
      pm = swapmax(pm);
      const bool first = st == 0;
      const float delta = first ? pm : fmaxf(pm, 0.f);
      const float al = first ? 1.f : __builtin_amdgcn_exp2f(-delta);
      m_run += delta; l_run *= al;
#pragma unroll
      for (int i = 0; i < 16; ++i) { O0[i] *= al; O1[i] *= al; S0[i] -= delta; S1[i] -= delta; NEGM[i] = -m_run; }
    }
#define VREAD(ds_) const u16* vp = sVb + (32 * (ds_) + r) * VLD + 4 * h; \
      const s16x4 a0 = *(const s16x4*)(vp), a1 = *(const s16x4*)(vp + 8), a2 = *(const s16x4*)(vp + 16), a3 = *(const s16x4*)(vp + 24); \
      const s16x4 a4 = *(const s16x4*)(vp + 32), a5 = *(const s16x4*)(vp + 40), a6 = *(const s16x4*)(vp + 48), a7 = *(const s16x4*)(vp + 56)
#define VCAT(x, y) __builtin_shufflevector(x, y, 0, 1, 2, 3, 4, 5, 6, 7)
    if (local && qt == 0) {
      float ps = 0.f;
#pragma unroll
      for (int i = 0; i < 16; ++i) { S0[i] = __builtin_amdgcn_exp2f(S0[i]); ps += S0[i]; }
#pragma unroll
      for (int i = 0; i < 4; ++i) { S1[i] = __builtin_amdgcn_exp2f(S1[i]); ps += S1[i]; }
      l_run += ps;
      const bf16x8 p00 = pack8(S0[0], S0[1], S0[2], S0[3], S0[4], S0[5], S0[6], S0[7]);
      const bf16x8 p01 = pack8(S0[8], S0[9], S0[10], S0[11], S0[12], S0[13], S0[14], S0[15]);
      const bf16x8 p10 = pack8(S1[0], S1[1], S1[2], S1[3], 0.f, 0.f, 0.f, 0.f);
      { VREAD(0); (void)a6; (void)a7; O0 = mfma32(VCAT(a0, a1), p00, O0); O0 = mfma32(VCAT(a2, a3), p01, O0); O0 = mfma32(VCAT(a4, a5), p10, O0); }
      { VREAD(1); (void)a6; (void)a7; O1 = mfma32(VCAT(a0, a1), p00, O1); O1 = mfma32(VCAT(a2, a3), p01, O1); O1 = mfma32(VCAT(a4, a5), p10, O1); }
      return;
    }
    if (local && qt == 1) {
      float ps = 0.f;
#pragma unroll
      for (int i = 12; i < 16; ++i) { S0[i] = __builtin_amdgcn_exp2f(S0[i]); ps += S0[i]; }
#pragma unroll
      for (int i = 0; i < 16; ++i) { S1[i] = __builtin_amdgcn_exp2f(S1[i]); ps += S1[i]; }
      l_run += ps;
      const bf16x8 p01 = pack8(0.f, 0.f, 0.f, 0.f, S0[12], S0[13], S0[14], S0[15]);
      const bf16x8 p10 = pack8(S1[0], S1[1], S1[2], S1[3], S1[4], S1[5], S1[6], S1[7]);
      const bf16x8 p11 = pack8(S1[8], S1[9], S1[10], S1[11], S1[12], S1[13], S1[14], S1[15]);
      { VREAD(0); (void)a0; (void)a1; O0 = mfma32(VCAT(a2, a3), p01, O0); O0 = mfma32(VCAT(a4, a5), p10, O0); O0 = mfma32(VCAT(a6, a7), p11, O0); }
      { VREAD(1); (void)a0; (void)a1; O1 = mfma32(VCAT(a2, a3), p01, O1); O1 = mfma32(VCAT(a4, a5), p10, O1); O1 = mfma32(VCAT(a6, a7), p11, O1); }
      return;
    }
#undef VREAD
#undef VCAT
    float ps = 0.f;
#pragma unroll
    for (int i = 0; i < 16; ++i) { S0[i] = __builtin_amdgcn_exp2f(S0[i]); S1[i] = __builtin_amdgcn_exp2f(S1[i]); ps += S0[i] + S1[i]; }
    l_run += ps;
    const bf16x8 p00 = pack8(S0[0], S0[1], S0[2], S0[3], S0[4], S0[5], S0[6], S0[7]);
    const bf16x8 p01 = pack8(S0[8], S0[9], S0[10], S0[11], S0[12], S0[13], S0[14], S0[15]);
    const bf16x8 p10 = pack8(S1[0], S1[1], S1[2], S1[3], S1[4], S1[5], S1[6], S1[7]);
    const bf16x8 p11 = pack8(S1[8], S1[9], S1[10], S1[11], S1[12], S1[13], S1[14], S1[15]);
#pragma unroll
    for (int ds = 0; ds < 2; ++ds) {
      const u16* vp = sVb + (32 * ds + r) * VLD + 4 * h;
      const s16x4 a0 = *(const s16x4*)(vp), a1 = *(const s16x4*)(vp + 8), a2 = *(const s16x4*)(vp + 16), a3 = *(const s16x4*)(vp + 24);
      const s16x4 a4 = *(const s16x4*)(vp + 32), a5 = *(const s16x4*)(vp + 40), a6 = *(const s16x4*)(vp + 48), a7 = *(const s16x4*)(vp + 56);
      const bf16x8 v00 = __builtin_shufflevector(a0, a1, 0, 1, 2, 3, 4, 5, 6, 7), v01 = __builtin_shufflevector(a2, a3, 0, 1, 2, 3, 4, 5, 6, 7);
      const bf16x8 v10 = __builtin_shufflevector(a4, a5, 0, 1, 2, 3, 4, 5, 6, 7), v11 = __builtin_shufflevector(a6, a7, 0, 1, 2, 3, 4, 5, 6, 7);
      if (ds == 0) { O0 = mfma32(v00, p00, O0); O0 = mfma32(v01, p01, O0); O0 = mfma32(v10, p10, O0); O0 = mfma32(v11, p11, O0); }
      else         { O1 = mfma32(v00, p00, O1); O1 = mfma32(v01, p01, O1); O1 = mfma32(v10, p10, O1); O1 = mfma32(v11, p11, O1); }
    }
  };
  const int nlast = nsteps - 1, npad = (MODE == 1 && it < 4096) ? 14 : ((nsteps + 1) & ~1);
  ATT_LOAD(a, 0);
  ATT_LOAD(b, min(1, nlast));
  for (int st = 0; st < npad; st += 2) {
    ATT_STORE(a, sK, sV);
    ATT_LOAD(a, min(st + 2, nlast));
    __syncthreads();
    compute(sK, sV, st);
    ATT_STORE(b, sK + SK_E, sV + SV_E);
    ATT_LOAD(b, min(st + 3, nlast));
    __syncthreads();
    compute(sK + SK_E, sV + SV_E, st + 1);
  }
#undef ATT_LOAD
#undef ATT_STORE
  {
    const float inv = 1.f / swapsum(l_run);
    const size_t mrow = (size_t)b * TB + tq;
    const u16* gp; u16* op = (u16*)(p.ws + OFF_H) + mrow * 1024 + hd * 64 + 4 * h;
    if (MODE == 0) gp = (const u16*)(p.ws + OFF_ZE) + mrow * 2048 + 416 + hd * 64 + 4 * h;
    else gp = (const u16*)(p.ws + OFF_ZO) + mrow * 3072 + 2048 + hd * 64 + 4 * h;
#pragma unroll
    for (int ds = 0; ds < 2; ++ds)
#pragma unroll
      for (int g = 0; g < 4; ++g) {
        const uint2 gv = *(const uint2*)(gp + 32 * ds + 8 * g);
        const float o0 = (ds ? O1[4 * g] : O0[4 * g]) * inv, o1 = (ds ? O1[4 * g + 1] : O0[4 * g + 1]) * inv;
        const float o2 = (ds ? O1[4 * g + 2] : O0[4 * g + 2]) * inv, o3 = (ds ? O1[4 * g + 3] : O0[4 * g + 3]) * inv;
        uint2 w = {pk2(o0 * silu(bflo(gv.x)), o1 * silu(bfhi(gv.x))), pk2(o2 * silu(bflo(gv.y)), o3 * silu(bfhi(gv.y)))};
        *(uint2*)(op + 32 * ds + 8 * g) = w;
      }
  }
  __syncthreads();
}


DI void mla_item8(const Params& p, int li, int it, char* smem) {
  constexpr int KLD = 104, KS = 6, VLD = 68, SK_E = 64 * KLD, SV_E = 64 * VLD;
  u16* sK = (u16*)smem;
  u16* sV = sK + 4 * SK_E;
  int tid = threadIdx.x; asm volatile("" : "+v"(tid));
  const int lane = tid & 63, wid = tid >> 6, r = lane & 31, h = lane >> 5;
  int bh, tqb, nsteps;
  if (it < 1024) { const int ch = it >> 8, w = it & 255; bh = ch * 8 + (w & 7); tqb = CTX + (w >> 3) * 256; nsteps = NCH; }
  else { bh = it - 1024; tqb = 0; nsteps = CTX / 64; }
  const int b = bh >> 3, hd = bh & 7;
  const int tq = tqb + wid * 32 + r;
  const u16* Qp = (const u16*)(p.ws + OFF_Q) + ((size_t)bh * TB + tq) * 96 + 8 * h;
  bf16x8 qf[KS];
#pragma unroll
  for (int s = 0; s < KS; ++s) qf[s] = *(const bf16x8*)(Qp + 16 * s);
  const int lkey = tid >> 3, lc8 = (tid & 7) * 8;
  const int rkey = tid >> 2, rc8 = (tid & 3) * 8;
  const u16* gK = (const u16*)(p.ws + OFF_KN) + ((size_t)bh * TB + lkey) * 64 + lc8;
  const u16* gR = (const u16*)(p.ws + OFF_KR) + ((size_t)b * TB + rkey) * 32 + rc8;
  const u16* gV = (const u16*)(p.ws + OFF_VTE) + ((size_t)bh * 64 + lkey) * TB + lc8;
  const int nlast = nsteps - 1;
  uint4 aK0, aK1, aR, aV0, aV1, bK0, bK1, bR, bV0, bV1;
#define LD_K(X, tile_) do { const int t0_ = min((tile_), nlast) * 64; \
    X##K0 = *(const uint4*)(gK + (size_t)t0_ * 64); if (wid < 4) X##R = *(const uint4*)(gR + (size_t)t0_ * 32); } while (0)
#define LD_V(X, tile_) do { const int t0_ = min((tile_), nlast) * 64; X##V0 = *(const uint4*)(gV + t0_); } while (0)
#define ST_K(X, kb_) do { u16* d_ = sK + (kb_) * SK_E; \
    *(uint4*)(d_ + lkey * KLD + lc8) = X##K0; if (wid < 4) *(uint4*)(d_ + rkey * KLD + 64 + rc8) = X##R; } while (0)
#define ST_V(X, vb_) do { u16* d_ = sV + (vb_) * SV_E; \
    *(uint2*)(d_ + lkey * VLD + lc8) = make_uint2(X##V0.x, X##V0.y); *(uint2*)(d_ + lkey * VLD + lc8 + 4) = make_uint2(X##V0.z, X##V0.w); } while (0)
  f32x16 O0, O1, NEGM;
#pragma unroll
  for (int i = 0; i < 16; ++i) { O0[i] = 0.f; O1[i] = 0.f; NEGM[i] = 0.f; }
  float m_run = 0.f, l_run = 0.f;
  constexpr float THR = 8.f;
  auto qk = [&](const u16* kb, f32x16& A0, f32x16& A1) {
    A0 = NEGM; A1 = NEGM;
#pragma unroll
    for (int s = 0; s < KS; ++s) {
      const bf16x8 k0 = *(const bf16x8*)(kb + r * KLD + 16 * s + 8 * h);
      const bf16x8 k1 = *(const bf16x8*)(kb + (32 + r) * KLD + 16 * s + 8 * h);
      A0 = mfma32(k0, qf[s], A0); A1 = mfma32(k1, qf[s], A1);
    }
  };
  auto check = [&](f32x16& A0, f32x16& A1, const bool first) {
    bool ex = false;
#pragma unroll
    for (int i = 0; i < 16; ++i) ex |= (A0[i] > THR) | (A1[i] > THR);
    if (__any(ex) || first) {
      float pm = fmaxf(A0[0], A1[0]);
#pragma unroll
      for (int i = 1; i < 16; ++i) pm = fmaxf(pm, fmaxf(A0[i], A1[i]));
      pm = swapmax(pm);
      const float delta = first ? pm : fmaxf(pm, 0.f);
      const float al = first ? 1.f : __builtin_amdgcn_exp2f(-delta);
      m_run += delta; l_run *= al;
#pragma unroll
      for (int i = 0; i < 16; ++i) { O0[i] *= al; O1[i] *= al; A0[i] -= delta; A1[i] -= delta; NEGM[i] = -m_run; }
    }
  };
  auto smpv = [&](f32x16& A0, f32x16& A1, const u16* vb) {
    float ps = 0.f;
#pragma unroll
    for (int i = 0; i < 16; ++i) { A0[i] = __builtin_amdgcn_exp2f(A0[i]); A1[i] = __builtin_amdgcn_exp2f(A1[i]); ps += A0[i] + A1[i]; }
    l_run += ps;
    const bf16x8 p00 = pack8(A0[0], A0[1], A0[2], A0[3], A0[4], A0[5], A0[6], A0[7]);
    const bf16x8 p01 = pack8(A0[8], A0[9], A0[10], A0[11], A0[12], A0[13], A0[14], A0[15]);
    const bf16x8 p10 = pack8(A1[0], A1[1], A1[2], A1[3], A1[4], A1[5], A1[6], A1[7]);
    const bf16x8 p11 = pack8(A1[8], A1[9], A1[10], A1[11], A1[12], A1[13], A1[14], A1[15]);
#pragma unroll
    for (int ds = 0; ds < 2; ++ds) {
      const u16* vp = vb + (32 * ds + r) * VLD + 4 * h;
      const s16x4 a0 = *(const s16x4*)(vp), a1 = *(const s16x4*)(vp + 8), a2 = *(const s16x4*)(vp + 16), a3 = *(const s16x4*)(vp + 24);
      const s16x4 a4 = *(const s16x4*)(vp + 32), a5 = *(const s16x4*)(vp + 40), a6 = *(const s16x4*)(vp + 48), a7 = *(const s16x4*)(vp + 56);
      const bf16x8 v00 = __builtin_shufflevector(a0, a1, 0, 1, 2, 3, 4, 5, 6, 7), v01 = __builtin_shufflevector(a2, a3, 0, 1, 2, 3, 4, 5, 6, 7);
      const bf16x8 v10 = __builtin_shufflevector(a4, a5, 0, 1, 2, 3, 4, 5, 6, 7), v11 = __builtin_shufflevector(a6, a7, 0, 1, 2, 3, 4, 5, 6, 7);
      if (ds == 0) { O0 = mfma32(v00, p00, O0); O0 = mfma32(v01, p01, O0); O0 = mfma32(v10, p10, O0); O0 = mfma32(v11, p11, O0); }
      else         { O1 = mfma32(v00, p00, O1); O1 = mfma32(v01, p01, O1); O1 = mfma32(v10, p10, O1); O1 = mfma32(v11, p11, O1); }
    }
  };
  LD_K(a, 0); LD_V(a, 0); LD_K(b, 1); LD_V(b, 1);
  ST_K(a, 0); ST_V(a, 0); ST_K(b, 1); ST_V(b, 1);
  LD_K(a, 2);
  ST_K(a, 2);
  LD_K(a, 3); LD_V(a, 2); LD_K(b, 4); LD_V(b, 3);
  __syncthreads();
  f32x16 Sc0, Sc1, Sn0, Sn1;
  qk(sK, Sc0, Sc1);
  check(Sc0, Sc1, true);
  __syncthreads();
  for (int j = 0; j < nsteps; j += 4) {
    ST_K(a, 3); ST_K(b, 0); ST_V(a, 2); ST_V(b, 3);
    LD_K(a, j + 5); LD_V(a, j + 4); LD_K(b, j + 6); LD_V(b, j + 5);
    qk(sK + 1 * SK_E, Sn0, Sn1);  smpv(Sc0, Sc1, sV + 0 * SV_E);  check(Sn0, Sn1, false);
    qk(sK + 2 * SK_E, Sc0, Sc1);  smpv(Sn0, Sn1, sV + 1 * SV_E);  check(Sc0, Sc1, false);
    __syncthreads();
    ST_K(a, 1); ST_K(b, 2); ST_V(a, 0); ST_V(b, 1);
    LD_K(a, j + 7); LD_V(a, j + 6); LD_K(b, j + 8); LD_V(b, j + 7);
    qk(sK + 3 * SK_E, Sn0, Sn1);  smpv(Sc0, Sc1, sV + 2 * SV_E);  check(Sn0, Sn1, false);
    qk(sK + 0 * SK_E, Sc0, Sc1);  smpv(Sn0, Sn1, sV + 3 * SV_E);  check(Sc0, Sc1, false);
    __syncthreads();
  }
#undef LD_K
#undef LD_V
#undef ST_K
#undef ST_V
  {
    const float inv = 1.f / swapsum(l_run);
    const size_t mrow = (size_t)b * TB + tq;
    u16* op = (u16*)(p.ws + OFF_H) + mrow * 1024 + hd * 64 + 4 * h;
    const u16* gp = (const u16*)(p.ws + OFF_ZE) + mrow * 2048 + 416 + hd * 64 + 4 * h;
#pragma unroll
    for (int ds = 0; ds < 2; ++ds)
#pragma unroll
      for (int g = 0; g < 4; ++g) {
        const uint2 gv = *(const uint2*)(gp + 32 * ds + 8 * g);
        const float o0 = (ds ? O1[4 * g] : O0[4 * g]) * inv, o1 = (ds ? O1[4 * g + 1] : O0[4 * g + 1]) * inv;
        const float o2 = (ds ? O1[4 * g + 2] : O0[4 * g + 2]) * inv, o3 = (ds ? O1[4 * g + 3] : O0[4 * g + 3]) * inv;
        uint2 w = {pk2(o0 * silu(bflo(gv.x)), o1 * silu(bfhi(gv.x))), pk2(o2 * silu(bflo(gv.y)), o3 * silu(bfhi(gv.y)))};
        *(uint2*)(op + 32 * ds + 8 * g) = w;
      }
  }
  __syncthreads();
}

DI void e3_carry_publish(const Params& p, unsigned* flag) {
  const int cw = pbid() - ((int)gridDim.x - 8);
  if (cw < 0) return;
  float* aggA = (float*)(p.ws + OFF_AGGA);
  float* aggH = (float*)(p.ws + OFF_AGGH);
  const int g = (cw * 2 + lhalf()) * 256 + ltid();
  const int b = g >> 10, d = (g >> 9) & 1, c = g & 511;
  const size_t ob = (size_t)b * NCH * 1024 + d * 512 + c;
  float hh = 0.f;
  for (int s0 = 0; s0 < NCH; s0 += 12) {
    float a[12], hv[12]; size_t o[12];
#pragma unroll
    for (int u = 0; u < 12; ++u) {
      const int s = s0 + u;
      const int j = d == 0 ? s : (s < 4 ? 3 - s : NCH + 3 - s);
      o[u] = ob + (size_t)j * 1024; a[u] = aggA[o[u]]; hv[u] = aggH[o[u]];
    }
#pragma unroll
    for (int u = 0; u < 12; ++u) { aggH[o[u]] = hh; hh = a[u] * hh + hv[u]; }
  }
  asm volatile("s_waitcnt vmcnt(0)" ::: "memory");
  __syncthreads();
  if (threadIdx.x == 0) {
    __builtin_amdgcn_fence(__ATOMIC_RELEASE, "agent");
    asm volatile("s_waitcnt vmcnt(0)" ::: "memory");
    (void)__hip_atomic_fetch_add(flag, 1u, __ATOMIC_RELAXED, __HIP_MEMORY_SCOPE_AGENT);
  }
}
DI void e3_carry_wait(unsigned* flag) {
  if (threadIdx.x == 0) {
    unsigned sp = 0u;
    while (__hip_atomic_load(flag, __ATOMIC_RELAXED, __HIP_MEMORY_SCOPE_AGENT) < 8u) { __builtin_amdgcn_s_sleep(4); if (++sp > (1u << 24)) break; }
    __builtin_amdgcn_fence(__ATOMIC_ACQUIRE, "agent");
    asm volatile("s_waitcnt vmcnt(0)" ::: "memory");
  }
  __syncthreads();
}
DI void phase_e3(const Params& p, int li, char* smem) {
  constexpr int N_LRU = NB * NCH * 8;
  unsigned* flag = (unsigned*)(p.ws + OFF_BAR) + 3520 + li * 64;
  e3_carry_publish(p, flag);
  for (int it = pbid(); it < 1024 + 32; it += (int)gridDim.x) mla_item8(p, li, it, smem - lhalf() * 65536);
  e3_carry_wait(flag);
  for (int it = lbid(); it < N_LRU; it += VGRID) lru_item<3>(p, li, it, smem);
}
DI void phase_na(const Params& p, int li, int nitems, char* smem) {
  for (int it = lbid(); it < nitems; it += VGRID) attn_item<1>(p, li, it, smem);
}


namespace pg8 {
#define PG8_LAS __attribute__((address_space(3)))
typedef unsigned short bf16_t;
typedef short bf16x8 __attribute__((ext_vector_type(8)));
typedef float f32x4 __attribute__((ext_vector_type(4)));
typedef unsigned u32x4 __attribute__((ext_vector_type(4)));
constexpr int BM = 256, BK = 64, HALF = 128, HTB = HALF * BK * 2  , STAGE_BYTES = 8 * HTB, NXCD = 8, WGM = 8;

__host__ __device__ __forceinline__ int lds_byte(int r, int c) { const int st = (r >> 4) * 2 + (c >> 5), rr = r & 15, cc = c & 31, ob = rr * 64 + cc * 2; return st * 1024 + (ob ^ (((ob >> 9) & 1) << 5)); }
__host__ __device__ __forceinline__ void stage_rc(int b, int& R, int& C) { const int st = b / 1024, sb = b % 1024, swz = sb ^ (((sb >> 9) & 1) << 5); R = (st >> 1) * 16 + swz / 64; C = (st & 1) * 32 + (swz % 64) / 2; }
__host__ __device__ __forceinline__ int perm32(int rho) { const int n = rho >> 4, i = rho & 15; return 8 * (i >> 2) + 4 * n + (i & 3); }

struct Unit { int pm, pn, kind; };
struct Gemm { const bf16_t* A; const bf16_t* Bt; int M, N, K; };
struct StaticOrder {
    int nM, nN, nwg, G, c;
    __host__ __device__ void init(int M, int N, int G_, int c_) { nM = M / BM; nN = N / BM; nwg = nM * nN; G = G_; c = c_; }
    __host__ __device__ bool next(int i, Unit& u) const { return at((long)i * G + c, u); }
    __device__ __forceinline__ const char* aptr(const Gemm& g, const Unit& u, size_t tstep) const { return (const char*)g.A + (size_t)u.pm * tstep; }
    __device__ __forceinline__ const char* bptr(const Gemm& g, const Unit& u, size_t tstep) const { return (const char*)g.Bt + (size_t)u.pn * tstep; }
    __host__ __device__ bool at(long L, Unit& u) const {
        u.kind = 0; if (L >= nwg) return false;
        int wgid = (int)L; { const int q = nwg / NXCD, r = nwg % NXCD, xcd = wgid % NXCD, off = wgid / NXCD; wgid = (xcd < r ? xcd * (q + 1) : r * (q + 1) + (xcd - r) * q) + off; }
        const int nig = WGM * nN, gid = wgid / nig, fm = gid * WGM, gsz = (nM - fm) < WGM ? (nM - fm) : WGM;
        u.pm = fm + ((wgid % nig) % gsz); u.pn = (wgid % nig) / gsz; return true;
    }
    __device__ __forceinline__ void a_ready(const Unit&) const {}
    __device__ __forceinline__ void done(const Unit&) const {}
};

__device__ __forceinline__ unsigned pk2f(float a, float b) { typedef __bf16 b2 __attribute__((ext_vector_type(2))); typedef float f2 __attribute__((ext_vector_type(2)));
    f2 f = {a, b}; b2 r = __builtin_convertvector(f, b2); return __builtin_bit_cast(unsigned, r); }
struct EpiStoreBf16 {
    static constexpr bool PERM = true, AFTER_DRAIN = false;
    bf16_t* O; int ldc; int split_cols; size_t split_stride;
    __device__ __forceinline__ void operator()(const f32x4 (&acc)[2][2][4][2], const Unit& u, int wr, int wc, int fr, int fq) const {
        const int row0 = u.pm * BM + wr * 64 + fr; int colt = u.pn * BM; bf16_t* base = O;
        if (split_cols) { const int t = colt / split_cols; base += (size_t)t * split_stride; colt -= t * split_cols; }
        const int col0 = colt + wc * 32 + 8 * fq;
#pragma unroll
        for (int ai = 0; ai < 2; ++ai)
#pragma unroll
            for (int m = 0; m < 4; ++m) { bf16_t* rowp = base + (size_t)(row0 + ai * HALF + m * 16) * ldc + col0;
#pragma unroll
                for (int bj = 0; bj < 2; ++bj) { const f32x4 v0 = acc[ai][bj][m][0], v1 = acc[ai][bj][m][1];
                    u32x4 w; w.x = pk2f(v0[0], v0[1]); w.y = pk2f(v0[2], v0[3]); w.z = pk2f(v1[0], v1[1]); w.w = pk2f(v1[2], v1[3]);
                    *(u32x4*)(rowp + bj * HALF) = w; } }
    }
};
struct EpiResid {
    static constexpr bool PERM = true, AFTER_DRAIN = false;
    const float* x_in; const float* ctx_in; const bf16_t* xb_in; bf16_t* xb_out; float* out32; const float* gate0; int L;
    __device__ __forceinline__ void operator()(const f32x4 (&acc)[2][2][4][2], const Unit& u, int wr, int wc, int fr, int fq) const {
        const int b = u.pm / 33, pt = u.pm - b * 33; const bool isctx = pt == 0;
        const float* gate = gate0 + (size_t)(isctx ? 4 : b) * 3072;
        const int col0 = u.pn * BM + wc * 32 + 8 * fq;
#pragma unroll
        for (int bj = 0; bj < 2; ++bj) {
            const int c = col0 + bj * HALF;
            const f32x4 g0 = *(const f32x4*)(gate + c), g1 = *(const f32x4*)(gate + c + 4);
#pragma unroll
            for (int ai = 0; ai < 2; ++ai)
#pragma unroll
                for (int m = 0; m < 4; ++m) {
                    const int lrow = wr * 64 + fr + ai * HALF + m * 16, t = pt * 256 + lrow;
                    const size_t grow = (size_t)u.pm * BM + lrow;
                    f32x4 x0, x1;
                    if (L == 0) { const float* src32 = (isctx ? ctx_in + ((size_t)b * 256 + t) * 1024 : x_in + ((size_t)b * 8192 + (t - 256)) * 1024) + c;
                        x0 = *(const f32x4*)(src32); x1 = *(const f32x4*)(src32 + 4); }
                    else { const u32x4 w = *(const u32x4*)(xb_in + grow * 1024 + c);
                        x0 = (f32x4){__uint_as_float(w.x << 16), __uint_as_float(w.x & 0xffff0000u), __uint_as_float(w.y << 16), __uint_as_float(w.y & 0xffff0000u)};
                        x1 = (f32x4){__uint_as_float(w.z << 16), __uint_as_float(w.z & 0xffff0000u), __uint_as_float(w.w << 16), __uint_as_float(w.w & 0xffff0000u)}; }
                    const f32x4 y0 = x0 + g0 * acc[ai][bj][m][0], y1 = x1 + g1 * acc[ai][bj][m][1];
                    if (L == 3) { float* dst32 = out32 + ((size_t)b * 8192 + (t - 256)) * 1024 + c; *(f32x4*)(dst32) = y0; *(f32x4*)(dst32 + 4) = y1; }
                    else { u32x4 w; w.x = pk2f(y0[0], y0[1]); w.y = pk2f(y0[2], y0[3]); w.z = pk2f(y1[0], y1[1]); w.w = pk2f(y1[2], y1[3]); *(u32x4*)(xb_out + grow * 1024 + c) = w; }
                }
        }
    }
};
struct LatentOrder {
    int G, c;
    __device__ bool next(int i, Unit& u) const { const int Lx = i * G + c; if (Lx >= 512) return false; const int lm = Lx >> 2; u.kind = 0; u.pn = Lx & 3; u.pm = (lm >> 5) * 33 + 1 + (lm & 31); return true; }
    __device__ __forceinline__ const char* aptr(const Gemm& g, const Unit& u, size_t tstep) const { return (const char*)g.A + (size_t)u.pm * tstep; }
    __device__ __forceinline__ const char* bptr(const Gemm& g, const Unit& u, size_t tstep) const { return (const char*)g.Bt + (size_t)u.pn * tstep; }
    __device__ __forceinline__ void a_ready(const Unit&) const {}
    __device__ __forceinline__ void done(const Unit&) const {}
};


struct OddOrder {
    StaticOrder s0, s1; const bf16_t* h; const bf16_t* W; int G, c;
    __device__ void init(const bf16_t* h_, const bf16_t* W_, int G_, int c_) { h = h_; W = W_; G = G_; c = c_; s0.init(33792, 3072, G_, c_); s1.init(1024, 33792, G_, c_); }
    __device__ bool next(int i, Unit& u) const { const long L = (long)i * G + c; if (L < s0.nwg) return s0.at(L, u); if (!s1.at(L - s0.nwg, u)) return false; u.kind = 1; return true; }
    __device__ __forceinline__ const char* aptr(const Gemm&, const Unit& u, size_t tstep) const { return (const char*)(u.kind ? W + (size_t)3072 * 1024 : h) + (size_t)u.pm * tstep; }
    __device__ __forceinline__ const char* bptr(const Gemm&, const Unit& u, size_t tstep) const { return (const char*)(u.kind ? h : W) + (size_t)u.pn * tstep; }
    __device__ __forceinline__ void a_ready(const Unit&) const {}
    __device__ __forceinline__ void done(const Unit&) const {}
};
struct EpiOdd {
    static constexpr bool PERM = true, AFTER_DRAIN = false;
    EpiStoreBf16 e0, e1;
    __device__ __forceinline__ void operator()(const f32x4 (&acc)[2][2][4][2], const Unit& u, int wr, int wc, int fr, int fq) const {
        if (u.kind) e1(acc, u, wr, wc, fr, fq); else e0(acc, u, wr, wc, fr, fq);
    }
};
template <class Epi, class Sched, bool STAMP = false>
__device__ __forceinline__ void gemm_phase(PG8_LAS unsigned char* lds, const Gemm g, const Sched& S, const Epi& E, unsigned long long* stamps) {
    int tid = threadIdx.x; asm volatile("" : "+v"(tid));
    const int wid = __builtin_amdgcn_readfirstlane(tid >> 6), lane = tid & 63, wr = wid >> 2, wc = wid & 3, fr = lane & 15, fq = lane >> 4;
    const int K = g.K, nt = K / BK;
    int ts_lo = 0, ts_hi = 0, nts = 0; const unsigned long long rt_entry = STAMP ? 0ull : 0ull;
#define PG8_STAMP() do { if (STAMP && wid == 0 && nts < 64) { const unsigned long long _c = 0ull; \
        ts_lo = (lane == nts) ? (int)(unsigned)_c : ts_lo; ts_hi = (lane == nts) ? (int)(unsigned)(_c >> 32) : ts_hi; ++nts; } } while (0)
    PG8_STAMP();
    unsigned voffA[2], voffB[2];
#pragma unroll
    for (int i = 0; i < 2; ++i) { int R, C; stage_rc(tid * 16 + i * 8192, R, C); const int Rb = Epi::PERM ? ((R & ~31) + perm32(R & 31)) : R;
        voffA[i] = (unsigned)(R * K + C) * 2u; voffB[i] = (unsigned)(Rb * K + C) * 2u; }
    const size_t kstep = (size_t)(BK * 2);
    const size_t hstep = (size_t)HALF * K * 2;
    const size_t tstep = 2 * hstep;
    const unsigned ldsw = (unsigned)wid * 1024u;
    const int aoff = lds_byte(wr * 64 + fr, fq * 8), boff = lds_byte(wc * 32 + fr, fq * 8);
#define PG8_SA(b, h) (((b) * 2 + (h)) * HTB)
#define PG8_SB(b, h) ((4 + (b) * 2 + (h)) * HTB)
#define PG8_STAGE(bufoff, gbase, voff) do { _Pragma("unroll") for (int _i = 0; _i < 2; ++_i) \
        __builtin_amdgcn_global_load_lds((const unsigned*)((const char*)(gbase) + (voff)[_i]), (PG8_LAS unsigned*)(lds + (bufoff) + ldsw + _i * 8192), 16, 0, 0); } while (0)
#define PG8_LDA(dst, b, h) do { _Pragma("unroll") for (int m = 0; m < 4; ++m) _Pragma("unroll") for (int k = 0; k < 2; ++k) dst[m][k] = *(const PG8_LAS bf16x8*)(lds + PG8_SA(b, h) + aoff + m * 2048 + k * 1024); } while (0)
#define PG8_LDB(dst, b, h) do { _Pragma("unroll") for (int n = 0; n < 2; ++n) _Pragma("unroll") for (int k = 0; k < 2; ++k) dst[n][k] = *(const PG8_LAS bf16x8*)(lds + PG8_SB(b, h) + boff + n * 2048 + k * 1024); } while (0)
#define PG8_MMA(ai, bj, At, Bt) do { __builtin_amdgcn_s_setprio(1); _Pragma("unroll") for (int m = 0; m < 4; ++m) _Pragma("unroll") for (int n = 0; n < 2; ++n) _Pragma("unroll") for (int k = 0; k < 2; ++k) \
        acc[ai][bj][m][n] = __builtin_amdgcn_mfma_f32_16x16x32_bf16(Bt[n][k], At[m][k], acc[ai][bj][m][n], 0, 0, 0); __builtin_amdgcn_s_setprio(0); } while (0)
#define PG8_WAIT_V(n) asm volatile("s_waitcnt vmcnt(" #n ")" ::: "memory")
#define PG8_WAIT_L(n) asm volatile("s_waitcnt lgkmcnt(" #n ")" ::: "memory")
#define PG8_BAR __builtin_amdgcn_s_barrier()
#define PG8_SCHED __builtin_amdgcn_sched_barrier(0)
    Unit cur, nxt; int ui = 0;
    if (!S.next(0, cur)) return;
    f32x4 acc[2][2][4][2];
#pragma unroll
    for (int a = 0; a < 2; ++a)
#pragma unroll
        for (int b = 0; b < 2; ++b)
#pragma unroll
            for (int m = 0; m < 4; ++m)
#pragma unroll
                for (int n = 0; n < 2; ++n) acc[a][b][m][n] = (f32x4){0.f, 0.f, 0.f, 0.f};
    bf16x8 At[4][2], B0[2][2], B1[2][2];
    const char* cA = S.aptr(g, cur, tstep); const char* cB = S.bptr(g, cur, tstep);
    S.a_ready(cur);
    PG8_STAGE(PG8_SB(0, 0), cB, voffB); PG8_STAGE(PG8_SA(0, 0), cA, voffA); PG8_STAGE(PG8_SB(0, 1), cB + hstep, voffB); PG8_STAGE(PG8_SA(0, 1), cA + hstep, voffA);
    if (wr == 1) PG8_BAR;
    PG8_WAIT_V(4); PG8_BAR;
    PG8_STAGE(PG8_SB(1, 0), cB + kstep, voffB); PG8_STAGE(PG8_SA(1, 0), cA + kstep, voffA); PG8_STAGE(PG8_SB(1, 1), cB + hstep + kstep, voffB);
    PG8_WAIT_V(6); PG8_BAR;
    PG8_STAMP();
    for (;;) {
        const bool has_next = S.next(ui + 1, nxt);
        const char* nA = has_next ? S.aptr(g, nxt, tstep) : cA; const char* nB = has_next ? S.bptr(g, nxt, tstep) : cB;
        for (int t = 0; t < nt; t += 2) {
            const bool last = (t == nt - 2);
            const char* a1 = cA + (size_t)(t + 1) * kstep;
            const char* a2 = last ? nA : cA + (size_t)(t + 2) * kstep; const char* b2 = last ? nB : cB + (size_t)(t + 2) * kstep;
            const char* a3 = a2 + kstep; const char* b3 = b2 + kstep;
            if (last && has_next) S.a_ready(nxt);
            PG8_LDB(B0, 0, 0); PG8_SCHED; PG8_LDA(At, 0, 0); PG8_STAGE(PG8_SA(1, 1), a1 + hstep, voffA);
            PG8_WAIT_L(8); PG8_BAR; PG8_WAIT_L(0); PG8_MMA(0, 0, At, B0); PG8_BAR; PG8_SCHED;
            PG8_LDB(B1, 0, 1); PG8_STAGE(PG8_SB(0, 0), b2, voffB);
            PG8_BAR; PG8_WAIT_L(0); PG8_MMA(0, 1, At, B1); PG8_BAR;
            PG8_LDA(At, 0, 1); PG8_STAGE(PG8_SA(0, 0), a2, voffA);
            PG8_BAR; PG8_WAIT_L(0); PG8_MMA(1, 0, At, B0); PG8_BAR; PG8_SCHED;
            PG8_STAGE(PG8_SB(0, 1), b2 + hstep, voffB);
            PG8_WAIT_V(6); PG8_BAR; PG8_MMA(1, 1, At, B1); PG8_BAR;
            PG8_LDB(B0, 1, 0); PG8_SCHED; PG8_LDA(At, 1, 0); PG8_STAGE(PG8_SA(0, 1), a2 + hstep, voffA);
            PG8_WAIT_L(8); PG8_BAR; PG8_WAIT_L(0); PG8_MMA(0, 0, At, B0); PG8_BAR; PG8_SCHED;
            PG8_LDB(B1, 1, 1); PG8_STAGE(PG8_SB(1, 0), b3, voffB);
            PG8_BAR; PG8_WAIT_L(0); PG8_MMA(0, 1, At, B1); PG8_BAR;
            PG8_LDA(At, 1, 1); PG8_STAGE(PG8_SA(1, 0), a3, voffA);
            PG8_BAR; PG8_WAIT_L(0); PG8_MMA(1, 0, At, B0); PG8_BAR; PG8_SCHED;
            PG8_STAGE(PG8_SB(1, 1), b3 + hstep, voffB);
            PG8_WAIT_V(6); PG8_BAR; PG8_MMA(1, 1, At, B1); PG8_BAR;
        }
        PG8_STAMP();
        if constexpr (!Epi::AFTER_DRAIN) { E(acc, cur, wr, wc, fr, fq); S.done(cur); }
        PG8_STAMP();
        if (!has_next) break;
#pragma unroll
        for (int a = 0; a < 2; ++a)
#pragma unroll
            for (int b = 0; b < 2; ++b)
#pragma unroll
                for (int m = 0; m < 4; ++m)
#pragma unroll
                    for (int n = 0; n < 2; ++n) acc[a][b][m][n] = (f32x4){0.f, 0.f, 0.f, 0.f};
        cur = nxt; cA = nA; cB = nB; ++ui;
    }
    PG8_WAIT_V(0);
    if (wr == 0) PG8_BAR;
    PG8_BAR;
    if constexpr (Epi::AFTER_DRAIN) { E.fused(acc, cur, wr, wc, fr, fq, lds, wid, lane); S.done(cur); }
    PG8_STAMP();
    if (STAMP && wid == 0) { stamps[lane] = lane < nts ? (((unsigned long long)(unsigned)ts_hi << 32) | (unsigned)ts_lo) : 0ull;
        if (lane == 62) stamps[62] = rt_entry; if (lane == 63) stamps[63] = 0ull; }
#undef PG8_STAMP
#undef PG8_SA
#undef PG8_SB
#undef PG8_STAGE
#undef PG8_LDA
#undef PG8_LDB
#undef PG8_MMA
#undef PG8_WAIT_V
#undef PG8_WAIT_L
#undef PG8_BAR
#undef PG8_SCHED
}
}


DI void phase_win_even8(const Params& p, int li, char* lds) {
  pg8::Gemm g{(const u16*)(p.ws + OFF_H), (const u16*)(p.ws + OFF_WINE + li * SZ_WINE), M, 2048, 1024};
  pg8::StaticOrder S; S.init(g.M, g.N, (int)gridDim.x, pbid());
  pg8::EpiStoreBf16 E{(u16*)(p.ws + OFF_ZE), 2048, 0, 0};
  pg8::gemm_phase<pg8::EpiStoreBf16, pg8::StaticOrder, false>((PG8_LAS unsigned char*)lds, g, S, E, nullptr);
}
DI void phase_win_odd8(const Params& p, int li, char* lds) {
  const u16* W = (const u16*)(p.ws + OFF_WINO + li * SZ_WINO);
  const u16* h = (const u16*)(p.ws + OFF_H);
  pg8::Gemm g{h, W, M, 3072, 1024};
  pg8::OddOrder S; S.init(h, W, (int)gridDim.x, pbid());
  pg8::EpiOdd E{pg8::EpiStoreBf16{(u16*)(p.ws + OFF_ZO), 3072, 0, 0}, pg8::EpiStoreBf16{(u16*)(p.ws + OFF_VTO), TB, TB, (size_t)1024 * TB}};
  pg8::gemm_phase<pg8::EpiOdd, pg8::OddOrder, false>((PG8_LAS unsigned char*)lds, g, S, E, nullptr);
}
DI void phase_out8(const Params& p, int L, char* lds) {
  const int li = L >> 1;
  pg8::Gemm g{(const u16*)(p.ws + OFF_H), (const u16*)(p.ws + ((L & 1) ? OFF_WOUTO : OFF_WOUTE) + li * SZ_WOUT), M, 1024, 1024};
  pg8::EpiResid E{p.x, p.ctx, (const u16*)(p.ws + OFF_XB), (u16*)(p.ws + OFF_XB), p.out, (const float*)(p.ws + OFF_MOD) + (size_t)L * 5 * 3072 + 2048, L};
  if (L == 3) {
    pg8::LatentOrder S{(int)gridDim.x, pbid()};
    pg8::gemm_phase<pg8::EpiResid, pg8::LatentOrder, false>((PG8_LAS unsigned char*)lds, g, S, E, nullptr);
  } else {
    pg8::StaticOrder S; S.init(g.M, g.N, (int)gridDim.x, pbid());
    pg8::gemm_phase<pg8::EpiResid, pg8::StaticOrder, false>((PG8_LAS unsigned char*)lds, g, S, E, nullptr);
  }
}

#define XB_TMO      128
#define XB_XCNT(j)  (256  + 64 * (j))
#define XB_XSUB(j)  (1280 + 64 * (j))
#define XB_XGEN(j)  (2304 + 64 * (j))
#define XB_TOP      3328
#define XB_TOPGEN   3392
#define XCD_BAR_WORDS 3456
#define XB_SPIN_CAP (1u << 22)
#define LAS __attribute__((address_space(3)))
DI unsigned xb_ld(unsigned* p)              { return __hip_atomic_load(p, __ATOMIC_RELAXED, __HIP_MEMORY_SCOPE_AGENT); }
DI unsigned xb_add(unsigned* p, unsigned v) { return __hip_atomic_fetch_add(p, v, __ATOMIC_RELAXED, __HIP_MEMORY_SCOPE_AGENT); }
DI unsigned xb_xcc_id() { return (unsigned)__builtin_amdgcn_s_getreg((3 << 11) | 20) & 0xFu; }
#define XB_SPIN(cond, bar) do { unsigned _sp = 0; while (cond) { __builtin_amdgcn_s_sleep(1); \
    if ((++_sp & 255u) == 0u) { if (xb_ld(&(bar)[XB_TMO])) break; if (_sp > XB_SPIN_CAP) { atomicAdd(&(bar)[XB_TMO], 1u); break; } } } } while (0)
struct XcdBarrier { unsigned* bar; unsigned x; volatile LAS unsigned* st; };
DI XcdBarrier xcd_barrier_post(unsigned* bar, volatile LAS unsigned* st) {
  XcdBarrier b; b.bar = bar; b.x = xb_xcc_id(); b.st = st;
  if (threadIdx.x == 0) (void)xb_add(&bar[XB_XCNT(b.x)], 1u);
  return b;
}
DI void xcd_barrier_complete(unsigned* bar, unsigned x, unsigned& nloc, unsigned& nx) {
  const unsigned G = gridDim.x * gridDim.y * gridDim.z;
  unsigned sum, cnt, mine, sp = 0u;
  for (;;) {
    sum = 0u; cnt = 0u; mine = 0u;
#pragma unroll
    for (unsigned j = 0; j < 16; ++j) { const unsigned c = xb_ld(&bar[XB_XCNT(j)]); sum += c; cnt += (c > 0u) ? 1u : 0u; mine = (j == x) ? c : mine; }
    if (sum == G) break;
    __builtin_amdgcn_s_sleep(1);
    if ((++sp & 255u) == 0u) { if (xb_ld(&bar[XB_TMO])) break; if (sp > XB_SPIN_CAP) { atomicAdd(&bar[XB_TMO], 1u); break; } }
  }
  nloc = mine > 0u ? mine : 1u; nx = cnt > 0u ? cnt : 1u;
}
DI void xcd_barrier(const XcdBarrier& b) {
  asm volatile("s_waitcnt vmcnt(0)" ::: "memory");
  __syncthreads();
  if (threadIdx.x == 0) {
    unsigned* bar = b.bar;
    __builtin_amdgcn_s_waitcnt(0);
    unsigned nloc = b.st[0], nx = b.st[1];
    if (nloc == 0u) { xcd_barrier_complete(bar, b.x, nloc, nx); b.st[0] = nloc; b.st[1] = nx; }
    const unsigned old = xb_add(&bar[XB_XSUB(b.x)], 1u);
    const unsigned gen = old / nloc;
    if (old + 1u == (gen + 1u) * nloc) {
      __builtin_amdgcn_fence(__ATOMIC_RELEASE, "agent");
      asm volatile("s_waitcnt vmcnt(0)" ::: "memory");
      const unsigned og = xb_add(&bar[XB_TOP], 1u);
      const unsigned tg = og / nx;
      if (og + 1u == (tg + 1u) * nx) xb_add(&bar[XB_TOPGEN], 1u);
      else XB_SPIN(xb_ld(&bar[XB_TOPGEN]) == tg, bar);
      __builtin_amdgcn_fence(__ATOMIC_ACQUIRE, "agent");
      xb_add(&bar[XB_XGEN(b.x)], 1u);
      asm volatile("s_waitcnt vmcnt(0)" ::: "memory");
    } else {
      XB_SPIN(xb_ld(&bar[XB_XGEN(b.x)]) == gen, bar);
      __builtin_amdgcn_fence(__ATOMIC_ACQUIRE, "agent");
      asm volatile("s_waitcnt vmcnt(0)" ::: "memory");
    }
  }
  __syncthreads();
}

DI void phase_lru_carry(const Params& p) {
  float* aggA = (float*)(p.ws + OFF_AGGA);
  float* aggH = (float*)(p.ws + OFF_AGGH);
  const int g = lbid() * 256 + ltid();
  if (g >= NB * 2 * 512) return;
  const int b = g >> 10, d = (g >> 9) & 1, c = g & 511;
  const size_t ob = (size_t)b * NCH * 1024 + d * 512 + c;
  float hh = 0.f;
  for (int s0 = 0; s0 < NCH; s0 += 12) {
    float a[12], hv[12]; size_t o[12];
#pragma unroll
    for (int u = 0; u < 12; ++u) {
      const int s = s0 + u;
      const int j = d == 0 ? s : (s < 4 ? 3 - s : NCH + 3 - s);
      o[u] = ob + (size_t)j * 1024; a[u] = aggA[o[u]]; hv[u] = aggH[o[u]];
    }
#pragma unroll
    for (int u = 0; u < 12; ++u) { aggH[o[u]] = hh; hh = a[u] * hh + hv[u]; }
  }
}

#ifndef DUP
#define DUP 0
#endif
#define REP(k) for (int rep_ = 0; rep_ < ((DUP) == (k) ? 2 : 1); ++rep_)
constexpr int HALF_LDS = 65536;
constexpr int DYN_LDS = 2 * HALF_LDS + 16;
__global__ void __launch_bounds__(512, 2) mega(Params p) {
  extern __shared__ __attribute__((aligned(16))) char dyn_smem[];
  char* smem = dyn_smem + lhalf() * HALF_LDS;
  uint4* xbw = (uint4*)(dyn_smem + 2 * HALF_LDS);
  cg::grid_group grid = cg::this_grid();
  if (threadIdx.x == 0) *xbw = make_uint4(0u, 0u, 0u, 0u);
  __syncthreads();
  const XcdBarrier xbar = xcd_barrier_post((unsigned*)(p.ws + OFF_BAR), (volatile LAS unsigned*)xbw);
  REP(9) phase_prep(p, smem);
  grid.sync();
  for (int L = 0; L < NLAYERS_RUN; ++L) {
    const int li = L >> 1;
    REP(1) phase_norm(p, L);
    do { xcd_barrier(xbar); if (DUP == 10) xcd_barrier(xbar); } while (0);
    if ((L & 1) == 0) {
      REP(2) phase_win_even8(p, li, dyn_smem);
      do { xcd_barrier(xbar); if (DUP == 10) xcd_barrier(xbar); } while (0);
      REP(3) phase_e2(p, li, smem);
      do { xcd_barrier(xbar); if (DUP == 10) xcd_barrier(xbar); } while (0);
      phase_e3(p, li, smem);
      do { xcd_barrier(xbar); if (DUP == 10) xcd_barrier(xbar); } while (0);
    } else {
      REP(6) phase_win_odd8(p, li, dyn_smem);
      do { xcd_barrier(xbar); if (DUP == 10) xcd_barrier(xbar); } while (0);
      REP(7) phase_na(p, li, L < 3 ? 4096 + 128 : 4096, smem);
      do { xcd_barrier(xbar); if (DUP == 10) xcd_barrier(xbar); } while (0);
    }
    phase_out8(p, L, dyn_smem);
    do { xcd_barrier(xbar); if (DUP == 10) xcd_barrier(xbar); } while (0);
  }
  phase_final_norm(p);
}

extern "C" void kernel_launch(void* const* d_in, const int* in_sizes, int n_in, void* d_out, int out_size, void* d_ws, size_t ws_size,
                              hipStream_t stream) {
  static int grid_blocks = 0;
  if (!grid_blocks) {
    int dev = 0, cus = 0, per_cu = 0;
    (void)hipGetDevice(&dev);
    (void)hipDeviceGetAttribute(&cus, hipDeviceAttributeMultiprocessorCount, dev);
    if (hipFuncSetAttribute((const void*)mega, hipFuncAttributeMaxDynamicSharedMemorySize, DYN_LDS) != hipSuccess) { fprintf(stderr, "kernel_launch: hipFuncSetAttribute(%d B LDS) failed\n", DYN_LDS); return; }
    (void)hipOccupancyMaxActiveBlocksPerMultiprocessor(&per_cu, mega, 512, DYN_LDS);
    (void)hipGetLastError();
    grid_blocks = cus & ~7;
  }
  if (ws_size < WS_NEED) { fprintf(stderr, "kernel_launch: workspace too small: %zu < %zu\n", ws_size, WS_NEED); return; }
  if (hipMemsetAsync((char*)d_ws + OFF_BAR, 0, 16384, stream) != hipSuccess) { fprintf(stderr, "kernel_launch: memset failed\n"); return; }
  Params p{};
  const float** f = (const float**)&p;
  for (int i = 0; i < 24; ++i) f[i] = (const float*)d_in[i];
  p.out = (float*)d_out;
  p.ws = (char*)d_ws;
  void* args[] = {&p};
  hipError_t e = hipLaunchCooperativeKernel((void*)mega, dim3(grid_blocks), dim3(512), args, DYN_LDS, stream);
  if (e != hipSuccess) fprintf(stderr, "cooperative launch failed: %s (grid %d)\n", hipGetErrorString(e), grid_blocks);
}
```

```cpp
#include <hip/hip_runtime.h>
#include <hip/hip_cooperative_groups.h>
#include <cstdio>
namespace cg = cooperative_groups;

#define DI __device__ __forceinline__
typedef unsigned short u16;
using bf16x8 = __attribute__((ext_vector_type(8))) short;
using s16x4  = __attribute__((ext_vector_type(4))) short;
using f32x16 = __attribute__((ext_vector_type(16))) float;
typedef __bf16 bf2_t __attribute__((ext_vector_type(2)));
typedef float fl2_t __attribute__((ext_vector_type(2)));

#ifndef NLAYERS_RUN
#define NLAYERS_RUN 4
#endif

constexpr int D = 1024, NB = 4, SEQ = 8192, CTX = 256, TB = SEQ + CTX, M = NB * TB;
constexpr int NCH = TB / 64;
constexpr float LOG2E = 1.4426950408889634f;
constexpr float MLA_QS = 0.10206207261596575f * LOG2E;
constexpr float RMS_EPS = 1e-6f;

constexpr size_t SZ_WINE = (size_t)2048 * 1024 * 2, SZ_WUQ = (size_t)768 * 256 * 2, SZ_WUKV = (size_t)1024 * 128 * 2;
constexpr size_t SZ_WOUT = (size_t)1024 * 1024 * 2, SZ_WINO = (size_t)4096 * 1024 * 2, SZ_WLRU = (size_t)32 * 4096 * 2;
constexpr size_t OFF_WINE = 0;
constexpr size_t OFF_WUQ = OFF_WINE + 2 * SZ_WINE;
constexpr size_t OFF_WUKV = OFF_WUQ + 2 * SZ_WUQ;
constexpr size_t OFF_WOUTE = OFF_WUKV + 2 * SZ_WUKV;
constexpr size_t OFF_WINO = OFF_WOUTE + 2 * SZ_WOUT;
constexpr size_t OFF_WOUTO = OFF_WINO + 2 * SZ_WINO;
constexpr size_t OFF_WA = OFF_WOUTO + 2 * SZ_WOUT;
constexpr size_t OFF_WX = OFF_WA + SZ_WLRU;
constexpr size_t OFF_MOD = OFF_WX + SZ_WLRU;
constexpr size_t SZ_MOD = (size_t)4 * 5 * 3072 * 4;
constexpr size_t OFF_CX = OFF_MOD + SZ_MOD;
constexpr size_t SZ_CX = (size_t)NB * CTX * D * 4;
constexpr size_t OFF_H = OFF_CX + SZ_CX;
constexpr size_t SZ_H = (size_t)M * D * 2;
constexpr size_t OFF_Z = OFF_H + SZ_H;
constexpr size_t OFF_ZE = OFF_Z;
constexpr size_t SZ_ZE = (size_t)M * 2048 * 2;
constexpr size_t OFF_Q = OFF_ZE + SZ_ZE;
constexpr size_t SZ_Q = (size_t)NB * 8 * TB * 96 * 2;
constexpr size_t OFF_KN = OFF_Q + SZ_Q;
constexpr size_t SZ_KN = (size_t)NB * 8 * TB * 64 * 2;
constexpr size_t OFF_KR = OFF_KN + SZ_KN;
constexpr size_t SZ_KR = (size_t)NB * TB * 32 * 2;
constexpr size_t OFF_VTE = OFF_KR + SZ_KR;
constexpr size_t SZ_VTE = (size_t)NB * 8 * 64 * TB * 2;
constexpr size_t OFF_AGGA = OFF_VTE + SZ_VTE;
constexpr size_t SZ_AGG = (size_t)NB * NCH * 2 * 512 * 4;
constexpr size_t OFF_AGGH = OFF_AGGA + SZ_AGG;
constexpr size_t END_EVEN = OFF_AGGH + SZ_AGG;
constexpr size_t OFF_ZO = OFF_Z;
constexpr size_t SZ_ZO = (size_t)M * 3072 * 2;
constexpr size_t OFF_VTO = OFF_ZO + SZ_ZO;
constexpr size_t SZ_VTO = (size_t)NB * 16 * 64 * TB * 2;
constexpr size_t END_ODD = OFF_VTO + SZ_VTO;
constexpr size_t OFF_BAR = END_EVEN > END_ODD ? END_EVEN : END_ODD;
constexpr size_t OFF_XB = OFF_BAR + 16384;
constexpr size_t WS_NEED = OFF_XB + (size_t)M * D * 2;

struct Params {
  const float *x, *c, *ctx, *c_ctx, *ada_w, *ada_b, *norm_g, *ev_w_in, *q_norm, *w_uq, *kv_norm, *w_ukv;
  const float *conv_w, *conv_b, *wa, *ba, *wx, *bx, *lam, *ev_w_out, *od_w_in, *rpb, *od_w_out, *fin_g;
  float* out;
  char* ws;
};

DI int ltid() { int t = threadIdx.x & 255; asm volatile("" : "+v"(t)); return t; }
DI int lhalf() { return __builtin_amdgcn_readfirstlane((int)(threadIdx.x >> 8)); }
DI int lbid() { const int b = blockIdx.x; int t = (b & 7) + 8 * (2 * (b >> 3) + lhalf()); asm volatile("" : "+s"(t)); return t; }
#define VGRID ((int)(gridDim.x * 2))
DI int pbid() { int t = blockIdx.x; asm volatile("" : "+s"(t)); return t; }
DI unsigned pk2(float a, float b) { fl2_t f = {a, b}; bf2_t r = __builtin_convertvector(f, bf2_t); return __builtin_bit_cast(unsigned, r); }
DI u16 f2bf(float a) { return (u16)(pk2(a, a) & 0xffffu); }
DI float bf2f(u16 v) { return __uint_as_float(((unsigned)v) << 16); }
DI float bflo(unsigned w) { return __uint_as_float(w << 16); }
DI float bfhi(unsigned w) { return __uint_as_float(w & 0xffff0000u); }
DI f32x16 mfma32(bf16x8 a, bf16x8 b, f32x16 c) { return __builtin_amdgcn_mfma_f32_32x32x16_bf16(a, b, c, 0, 0, 0); }
DI int crow(int i, int h) { return (i & 3) + 8 * (i >> 2) + 4 * h; }
DI float silu(float g) { return g * __builtin_amdgcn_rcpf(1.f + __expf(-g)); }
DI float sigmoidf(float g) { return __builtin_amdgcn_rcpf(1.f + __expf(-g)); }
DI float swapmax(float v) { auto rr = __builtin_amdgcn_permlane32_swap(__float_as_uint(v), __float_as_uint(v), false, false);
  return fmaxf(__uint_as_float(rr[0]), __uint_as_float(rr[1])); }
DI float swapsum(float v) { auto rr = __builtin_amdgcn_permlane32_swap(__float_as_uint(v), __float_as_uint(v), false, false);
  return __uint_as_float(rr[0]) + __uint_as_float(rr[1]); }
DI float wave_sum(float v) {
#pragma unroll
  for (int o = 32; o >= 1; o >>= 1) v += __shfl_xor(v, o);
  return v; }
DI bf16x8 pack8(float a0, float a1, float a2, float a3, float a4, float a5, float a6, float a7) {
  uint4 w = {pk2(a0, a1), pk2(a2, a3), pk2(a4, a5), pk2(a6, a7)}; return __builtin_bit_cast(bf16x8, w); }

constexpr int GLD = 72;
template <bool SUMSQ>
DI void gemm_core(const u16* __restrict__ P, int ldp, const u16* __restrict__ Q, int ldq, int K,
                  u16* sP, u16* sQ, f32x16 (&acc)[2][2], float (&ss)[2]) {
  const int tid = ltid(), lane = tid & 63, wid = tid >> 6, r = lane & 31, h = lane >> 5, wm = wid >> 1, wn = wid & 1;
  const int lr = tid >> 3, lc = (tid & 7) * 8;
  uint4 rp0, rp1, rp2, rp3, rq0, rq1, rq2, rq3;
#pragma unroll
  for (int a = 0; a < 2; ++a)
#pragma unroll
    for (int b = 0; b < 2; ++b)
#pragma unroll
      for (int i = 0; i < 16; ++i) acc[a][b][i] = 0.f;
  ss[0] = 0.f; ss[1] = 0.f;
  const u16* Pg = P + (size_t)lr * ldp + lc;
  const u16* Qg = Q + (size_t)lr * ldq + lc;
#define GLOADPQ(KO) do { \
    rp0 = *(const uint4*)(Pg + (KO)); rp1 = *(const uint4*)(Pg + (size_t)32 * ldp + (KO)); \
    rp2 = *(const uint4*)(Pg + (size_t)64 * ldp + (KO)); rp3 = *(const uint4*)(Pg + (size_t)96 * ldp + (KO)); \
    rq0 = *(const uint4*)(Qg + (KO)); rq1 = *(const uint4*)(Qg + (size_t)32 * ldq + (KO)); \
    rq2 = *(const uint4*)(Qg + (size_t)64 * ldq + (KO)); rq3 = *(const uint4*)(Qg + (size_t)96 * ldq + (KO)); } while (0)
  GLOADPQ(0);
  if (lhalf()) __syncthreads();
  for (int k0 = 0; k0 < K; k0 += 64) {
    __syncthreads();
    *(uint4*)(sP + (lr) * GLD + lc) = rp0; *(uint4*)(sP + (lr + 32) * GLD + lc) = rp1;
    *(uint4*)(sP + (lr + 64) * GLD + lc) = rp2; *(uint4*)(sP + (lr + 96) * GLD + lc) = rp3;
    *(uint4*)(sQ + (lr) * GLD + lc) = rq0; *(uint4*)(sQ + (lr + 32) * GLD + lc) = rq1;
    *(uint4*)(sQ + (lr + 64) * GLD + lc) = rq2; *(uint4*)(sQ + (lr + 96) * GLD + lc) = rq3;
    __syncthreads();
    if (k0 + 64 < K) GLOADPQ(k0 + 64);
#pragma unroll
    for (int s = 0; s < 4; ++s) {
      const bf16x8 a0 = *(const bf16x8*)(sP + (wm * 64 + r) * GLD + s * 16 + h * 8);
      const bf16x8 a1 = *(const bf16x8*)(sP + (wm * 64 + 32 + r) * GLD + s * 16 + h * 8);
      const bf16x8 b0 = *(const bf16x8*)(sQ + (wn * 64 + r) * GLD + s * 16 + h * 8);
      const bf16x8 b1 = *(const bf16x8*)(sQ + (wn * 64 + 32 + r) * GLD + s * 16 + h * 8);
      if (SUMSQ) {
#pragma unroll
        for (int j = 0; j < 8; ++j) { float f0 = bf2f((u16)b0[j]), f1 = bf2f((u16)b1[j]); ss[0] += f0 * f0; ss[1] += f1 * f1; }
      }
      acc[0][0] = mfma32(a0, b0, acc[0][0]); acc[0][1] = mfma32(a0, b1, acc[0][1]);
      acc[1][0] = mfma32(a1, b0, acc[1][0]); acc[1][1] = mfma32(a1, b1, acc[1][1]);
    }
  }
  if (!lhalf()) __syncthreads();
}

DI void epi_store_rows(const f32x16 (&acc)[2][2], u16* C, int ldc, int m0, int n0, int nvalid) {
  const int tid = ltid(), lane = tid & 63, wid = tid >> 6, r = lane & 31, h = lane >> 5, wm = wid >> 1, wn = wid & 1;
#pragma unroll
  for (int ni = 0; ni < 2; ++ni) {
    const int nb = n0 + wn * 64 + ni * 32;
    if (nb >= nvalid) continue;
#pragma unroll
    for (int mi = 0; mi < 2; ++mi)
#pragma unroll
      for (int i = 0; i < 16; ++i) {
        const int m = m0 + wm * 64 + mi * 32 + crow(i, h);
        C[(size_t)m * ldc + nb + r] = f2bf(acc[mi][ni][i]);
      }
  }
}
DI void epi_store_vt(const f32x16 (&acc)[2][2], u16* Vt, int nheads, int m0, int nn0) {
  const int tid = ltid(), lane = tid & 63, wid = tid >> 6, r = lane & 31, h = lane >> 5, wm = wid >> 1, wn = wid & 1;
  const int b = m0 / TB, tb0 = m0 % TB;
#pragma unroll
  for (int ni = 0; ni < 2; ++ni) {
    const int nn = nn0 + wn * 64 + ni * 32 + r, hd = nn >> 6, d = nn & 63;
    u16* base = Vt + ((size_t)(b * nheads + hd) * 64 + d) * TB + tb0 + wm * 64 + 4 * h;
#pragma unroll
    for (int mi = 0; mi < 2; ++mi)
#pragma unroll
      for (int g = 0; g < 4; ++g) {
        uint2 w = {pk2(acc[mi][ni][4 * g], acc[mi][ni][4 * g + 1]), pk2(acc[mi][ni][4 * g + 2], acc[mi][ni][4 * g + 3])};
        *(uint2*)(base + mi * 32 + 8 * g) = w;
      }
  }
}

DI void prep_tile(const float* __restrict__ src, int lds_, int nsrc, int k0, int n0, u16* __restrict__ dst, int K, int dn0,
                  const float* __restrict__ rowscale, float cscale, float* sT) {
  const int tid = ltid();
#pragma unroll
  for (int i = 0; i < 4; ++i) {
    const int idx = tid + 256 * i, kk = idx >> 4, n4 = (idx & 15) * 4;
    const bool ok = n0 + n4 < nsrc;
    float4 v = *(const float4*)(src + (size_t)(k0 + kk) * lds_ + (ok ? n0 + n4 : 0));
    if (!ok) v = make_float4(0.f, 0.f, 0.f, 0.f);
    const float sc = cscale * (rowscale ? rowscale[k0 + kk] : 1.f);
    sT[(n4 + 0) * 65 + kk] = v.x * sc; sT[(n4 + 1) * 65 + kk] = v.y * sc; sT[(n4 + 2) * 65 + kk] = v.z * sc; sT[(n4 + 3) * 65 + kk] = v.w * sc;
  }
  __syncthreads();
#pragma unroll
  for (int i = 0; i < 2; ++i) {
    const int idx = tid + 256 * i, n = idx >> 3, c = (idx & 7) * 8;
    const float* s = sT + n * 65 + c;
    uint4 w = {pk2(s[0], s[1]), pk2(s[2], s[3]), pk2(s[4], s[5]), pk2(s[6], s[7])};
    *(uint4*)(dst + (size_t)(dn0 + n) * K + k0 + c) = w;
  }
  __syncthreads();
}

DI void phase_prep(const Params& p, char* smem) {
  const int tid = ltid(), lane = tid & 63, wid = tid >> 6;
  constexpr int NADA = 192, PER_I = 512 + 48 + 32 + 256 + 1024 + 256, NTOT = NADA + 2 * PER_I + 64;
  for (int it = lbid(); it < NTOT; it += VGRID) {
    if (it < NADA) {
      const int layer = it / 48, j = (it % 48) * 64 + lane;
      float* sCond = (float*)smem;
      float* sRed = sCond + 5 * 1024;
      for (int e = tid; e < 5 * 1024; e += 256) { const float v = e < 4096 ? p.c[e] : p.c_ctx[e - 4096]; sCond[e] = silu(v); }
      __syncthreads();
      float a0 = 0.f, a1 = 0.f, a2 = 0.f, a3 = 0.f, a4 = 0.f;
      const float* w = p.ada_w + ((size_t)layer * 1024 + wid * 256) * 3072 + j;
      const float* sc = sCond + wid * 256;
#pragma unroll 8
      for (int k = 0; k < 256; ++k) {
        const float wv = w[(size_t)k * 3072];
        a0 += sc[k] * wv; a1 += sc[1024 + k] * wv; a2 += sc[2048 + k] * wv; a3 += sc[3072 + k] * wv; a4 += sc[4096 + k] * wv;
      }
      sRed[(wid * 5 + 0) * 64 + lane] = a0; sRed[(wid * 5 + 1) * 64 + lane] = a1; sRed[(wid * 5 + 2) * 64 + lane] = a2;
      sRed[(wid * 5 + 3) * 64 + lane] = a3; sRed[(wid * 5 + 4) * 64 + lane] = a4;
      __syncthreads();
      if (tid < 64) {
        float* mod = (float*)(p.ws + OFF_MOD);
        const float bias = p.ada_b[layer * 3072 + j];
#pragma unroll
        for (int rw = 0; rw < 5; ++rw) {
          const float s = sRed[(0 * 5 + rw) * 64 + lane] + sRed[(1 * 5 + rw) * 64 + lane] + sRed[(2 * 5 + rw) * 64 + lane] + sRed[(3 * 5 + rw) * 64 + lane];
          mod[((size_t)layer * 5 + rw) * 3072 + j] = s + bias;
        }
      }
      __syncthreads();
      continue;
    }
    int q = it - NADA;
    float* sT = (float*)smem;
    if (q < 2 * PER_I) {
      const int i = q / PER_I; q -= i * PER_I;
      if (q < 512) {
        const int kt = q & 15, nt = q >> 4;
        prep_tile(p.ev_w_in + (size_t)i * 1024 * 1952, 1952, 1952, kt * 64, nt * 64, (u16*)(p.ws + OFF_WINE + i * SZ_WINE), 1024, nt * 64, nullptr, 1.f, sT);
      } else if (q < 560) {
        q -= 512; const int kt = q & 3, nt = q >> 2;
        prep_tile(p.w_uq + (size_t)i * 256 * 768, 768, 768, kt * 64, nt * 64, (u16*)(p.ws + OFF_WUQ + i * SZ_WUQ), 256, nt * 64, p.q_norm + i * 256, 1.f, sT);
      } else if (q < 592) {
        q -= 560; const int kt = q & 1, nt = q >> 1;
        prep_tile(p.w_ukv + (size_t)i * 128 * 1024, 1024, 1024, kt * 64, nt * 64, (u16*)(p.ws + OFF_WUKV + i * SZ_WUKV), 128, nt * 64, p.kv_norm + i * 128, 1.f, sT);
      } else if (q < 848) {
        q -= 592; const int kt = q & 15, nt = q >> 4;
        prep_tile(p.ev_w_out + (size_t)i * 1024 * 1024, 1024, 1024, kt * 64, nt * 64, (u16*)(p.ws + OFF_WOUTE + i * SZ_WOUT), 1024, nt * 64, nullptr, 1.f, sT);
      } else if (q < 1872) {
        q -= 848; const int kt = q & 15, nt = q >> 4;
        const int n0 = nt * 64, reg = n0 >> 10;
        const int dn0 = (reg == 2 ? 3072 : reg == 3 ? 2048 : reg * 1024) + (n0 & 1023);
        prep_tile(p.od_w_in + (size_t)i * 1024 * 4096, 4096, 4096, kt * 64, n0, (u16*)(p.ws + OFF_WINO + i * SZ_WINO), 1024, dn0, nullptr, reg == 0 ? 0.125f * LOG2E : 1.f, sT);
      } else {
        q -= 1872; const int kt = q & 15, nt = q >> 4;
        prep_tile(p.od_w_out + (size_t)i * 1024 * 1024, 1024, 1024, kt * 64, nt * 64, (u16*)(p.ws + OFF_WOUTO + i * SZ_WOUT), 1024, nt * 64, nullptr, 1.f, sT);
      }
    } else {
      q -= 2 * PER_I;
      if (q < 32) prep_tile(p.wa + (size_t)q * 4096, 64, 64, 0, 0, (u16*)(p.ws + OFF_WA) + (size_t)q * 4096, 64, 0, nullptr, 1.f, sT);
      else { q -= 32; prep_tile(p.wx + (size_t)q * 4096, 64, 64, 0, 0, (u16*)(p.ws + OFF_WX) + (size_t)q * 4096, 64, 0, nullptr, 1.f, sT); }
    }
  }
}

DI const float* resid_in(const Params& p, int L, int b, int t) {
  if (t < CTX) return (L == 0 ? p.ctx : (const float*)(p.ws + OFF_CX)) + ((size_t)b * CTX + t) * D;
  return (L == 0 ? p.x : (const float*)p.out) + ((size_t)b * SEQ + (t - CTX)) * D;
}
DI float* resid_out(const Params& p, int b, int t) {
  if (t < CTX) return (float*)(p.ws + OFF_CX) + ((size_t)b * CTX + t) * D;
  return p.out + ((size_t)b * SEQ + (t - CTX)) * D;
}

DI void phase_norm(const Params& p, int L) {
  const int tid = ltid(), lane = tid & 63, wid = tid >> 6;
  const float* mod = (const float*)(p.ws + OFF_MOD);
  u16* hbuf = (u16*)(p.ws + OFF_H);
  for (int it = lbid(); it < M / 4; it += VGRID) {
    const int m = it * 4 + wid, b = m / TB, t = m % TB, mrow = t < CTX ? 4 : b;
    float4 v[4]; float ssq = 0.f;
    if (L == 0) {
      const float4* src = (const float4*)resid_in(p, 0, b, t);
#pragma unroll
      for (int j = 0; j < 4; ++j) v[j] = src[lane + 64 * j];
    } else {
      const uint2* src = (const uint2*)((const u16*)(p.ws + OFF_XB) + (size_t)m * 1024);
#pragma unroll
      for (int j = 0; j < 4; ++j) { const uint2 w = src[lane + 64 * j]; v[j] = make_float4(bflo(w.x), bfhi(w.x), bflo(w.y), bfhi(w.y)); }
    }
#pragma unroll
    for (int j = 0; j < 4; ++j) ssq += v[j].x * v[j].x + v[j].y * v[j].y + v[j].z * v[j].z + v[j].w * v[j].w;
    ssq = wave_sum(ssq);
    const float rs = rsqrtf(ssq * (1.f / 1024.f) + RMS_EPS);
    const float4* g4 = (const float4*)(p.norm_g + L * 1024);
    const float4* sh4 = (const float4*)(mod + ((size_t)L * 5 + mrow) * 3072);
    const float4* sc4 = sh4 + 256;
#pragma unroll
    for (int j = 0; j < 4; ++j) {
      const int k4 = lane + 64 * j;
      const float4 g = g4[k4], sh = sh4[k4], sc = sc4[k4];
      const float y0 = v[j].x * rs * g.x * (1.f + sc.x) + sh.x, y1 = v[j].y * rs * g.y * (1.f + sc.y) + sh.y;
      const float y2 = v[j].z * rs * g.z * (1.f + sc.z) + sh.z, y3 = v[j].w * rs * g.w * (1.f + sc.w) + sh.w;
      uint2 w = {pk2(y0, y1), pk2(y2, y3)};
      *(uint2*)(hbuf + (size_t)m * 1024 + k4 * 4) = w;
    }
  }
}

DI void phase_final_norm(const Params& p) {
  const int tid = ltid(), lane = tid & 63, wid = tid >> 6;
  for (int it = lbid(); it < NB * SEQ / 4; it += VGRID) {
    const int m = it * 4 + wid;
    float4* row = (float4*)(p.out + (size_t)m * 1024);
    float4 v[4]; float ssq = 0.f;
#pragma unroll
    for (int j = 0; j < 4; ++j) { v[j] = row[lane + 64 * j]; ssq += v[j].x * v[j].x + v[j].y * v[j].y + v[j].z * v[j].z + v[j].w * v[j].w; }
    ssq = wave_sum(ssq);
    const float rs = rsqrtf(ssq * (1.f / 1024.f) + RMS_EPS);
    const float4* g4 = (const float4*)p.fin_g;
#pragma unroll
    for (int j = 0; j < 4; ++j) {
      const float4 g = g4[lane + 64 * j];
      row[lane + 64 * j] = make_float4(v[j].x * rs * g.x, v[j].y * rs * g.y, v[j].z * rs * g.z, v[j].w * rs * g.w);
    }
  }
}

DI void phase_win_even(const Params& p, int li, char* smem) {
  u16* sP = (u16*)smem; u16* sQ = sP + 128 * GLD;
  const u16* A = (const u16*)(p.ws + OFF_H);
  const u16* W = (const u16*)(p.ws + OFF_WINE + li * SZ_WINE);
  u16* Z = (u16*)(p.ws + OFF_ZE);
  for (int it = lbid(); it < (M / 128) * 16; it += VGRID) {
    const int mt = it >> 4, nt = it & 15;
    f32x16 acc[2][2]; float ss[2];
    gemm_core<false>(A + (size_t)mt * 128 * 1024, 1024, W + (size_t)nt * 128 * 1024, 1024, 1024, sP, sQ, acc, ss);
    epi_store_rows(acc, Z, 2048, mt * 128, nt * 128, 1952);
  }
}
DI void phase_win_odd(const Params& p, int li, char* smem) {
  u16* sP = (u16*)smem; u16* sQ = sP + 128 * GLD;
  const u16* A = (const u16*)(p.ws + OFF_H);
  const u16* W = (const u16*)(p.ws + OFF_WINO + li * SZ_WINO);
  u16* Z = (u16*)(p.ws + OFF_ZO);
  u16* Vt = (u16*)(p.ws + OFF_VTO);
  for (int it = lbid(); it < (M / 128) * 32; it += VGRID) {
    const int mt = it >> 5, nt = it & 31;
    f32x16 acc[2][2]; float ss[2];
    gemm_core<false>(A + (size_t)mt * 128 * 1024, 1024, W + (size_t)nt * 128 * 1024, 1024, 1024, sP, sQ, acc, ss);
    if (nt < 24) epi_store_rows(acc, Z, 3072, mt * 128, nt * 128, 3072);
    else epi_store_vt(acc, Vt, 16, mt * 128, nt * 128 - 3072);
  }
}

DI void phase_out(const Params& p, int L, char* smem, bool dry = false) {
  u16* sP = (u16*)smem; u16* sQ = sP + 128 * GLD;
  const int li = L >> 1;
  const u16* A = (const u16*)(p.ws + OFF_H);
  const u16* W = (const u16*)(p.ws + ((L & 1) ? OFF_WOUTO : OFF_WOUTE) + li * SZ_WOUT);
  const float* mod = (const float*)(p.ws + OFF_MOD);
  const int tid = ltid(), lane = tid & 63, wid = tid >> 6, r = lane & 31, h = lane >> 5, wm = wid >> 1, wn = wid & 1;
  for (int it = lbid(); it < (M / 128) * 8; it += VGRID) {
    const int mt = it >> 3, nt = it & 7;
    const int m0 = mt * 128, b = m0 / TB, tb0 = m0 % TB;
    const bool isctx = tb0 < CTX;
    if (isctx && L == 3) continue;
    f32x16 acc[2][2]; float ss[2];
    gemm_core<false>(A + (size_t)m0 * 1024, 1024, W + (size_t)nt * 128 * 1024, 1024, 1024, sP, sQ, acc, ss);
    const float* rin32 = resid_in(p, 0, b, tb0);
    u16* xb = (u16*)(p.ws + (dry ? OFF_Z : OFF_XB)) + (size_t)m0 * 1024;
    const u16* xin = (const u16*)(p.ws + OFF_XB) + (size_t)m0 * 1024;
    float* rout32 = p.out + ((size_t)b * SEQ + (tb0 - CTX)) * D;
    const float* gate = mod + ((size_t)L * 5 + (isctx ? 4 : b)) * 3072 + 2048;
#pragma unroll
    for (int ni = 0; ni < 2; ++ni) {
      const int n = nt * 128 + wn * 64 + ni * 32 + r;
      const float gt = gate[n];
#pragma unroll
      for (int mi = 0; mi < 2; ++mi)
#pragma unroll
        for (int i = 0; i < 16; ++i) {
          const size_t o = (size_t)(wm * 64 + mi * 32 + crow(i, h)) * 1024 + n;
          const float xv = L == 0 ? rin32[o] : bf2f(xin[o]);
          const float y = xv + gt * acc[mi][ni][i];
          if (L == 3 && !dry) rout32[o] = y; else xb[o] = f2bf(y);
        }
    }
  }
}

DI void qproj_tile(const Params& p, int li, int mt, int nt, char* smem) {
  u16* sP = (u16*)smem; u16* sQ = sP + 128 * GLD;
  const int tid = ltid(), lane = tid & 63, wid = tid >> 6, r = lane & 31, h = lane >> 5, wm = wid >> 1, wn = wid & 1;
  const u16* W = (const u16*)(p.ws + OFF_WUQ + li * SZ_WUQ);
  const u16* Z = (const u16*)(p.ws + OFF_ZE);
  u16* Qb = (u16*)(p.ws + OFF_Q);
  f32x16 acc[2][2]; float ss[2];
  gemm_core<true>(W + (size_t)nt * 128 * 256, 256, Z + (size_t)mt * 128 * 2048, 2048, 256, sP, sQ, acc, ss);
#pragma unroll
  for (int ni = 0; ni < 2; ++ni) {
    const float rs = rsqrtf(swapsum(ss[ni]) * (1.f / 256.f) + RMS_EPS);
    const int m = mt * 128 + wn * 64 + ni * 32 + r, b = m / TB, t = m % TB;
    const int pos = t - CTX;
    const float prow = (float)(pos >> 6), pcol = (float)(pos & 63);
#pragma unroll
    for (int mi = 0; mi < 2; ++mi) {
      const int gt = (nt * 128 + wm * 64 + mi * 32) >> 5, hd = gt / 3, part = gt % 3;
      float v[16];
#pragma unroll
      for (int i = 0; i < 16; ++i) v[i] = acc[mi][ni][i] * rs;
      if (part == 2 && t >= CTX) {
#pragma unroll
        for (int i = 0; i < 4; ++i) {
          const float inv = exp2f(-(float)(4 * h + i) * 1.6609640474436813f);
          float ar = prow * inv, ac = pcol * inv;
          const float cr = __cosf(ar), sr = __sinf(ar), cc = __cosf(ac), sc = __sinf(ac);
          const float x1 = v[i], x2 = v[i + 4], y1 = v[8 + i], y2 = v[12 + i];
          v[i] = x1 * cr - x2 * sr; v[i + 4] = x2 * cr + x1 * sr;
          v[8 + i] = y1 * cc - y2 * sc; v[12 + i] = y2 * cc + y1 * sc;
        }
      }
      u16* dst = Qb + ((size_t)(b * 8 + hd) * TB + t) * 96 + part * 32 + 4 * h;
#pragma unroll
      for (int g = 0; g < 4; ++g) {
        uint2 w = {pk2(v[4 * g] * MLA_QS, v[4 * g + 1] * MLA_QS), pk2(v[4 * g + 2] * MLA_QS, v[4 * g + 3] * MLA_QS)};
        *(uint2*)(dst + 8 * g) = w;
      }
    }
  }
}
DI void kvproj_tile(const Params& p, int li, int mt, int nt, char* smem) {
  u16* sP = (u16*)smem; u16* sQ = sP + 128 * GLD;
  const int tid = ltid(), lane = tid & 63, wid = tid >> 6, r = lane & 31, h = lane >> 5, wm = wid >> 1, wn = wid & 1;
  const u16* W = (const u16*)(p.ws + OFF_WUKV + li * SZ_WUKV);
  const u16* Z = (const u16*)(p.ws + OFF_ZE);
  u16* Kn = (u16*)(p.ws + OFF_KN);
  u16* Vt = (u16*)(p.ws + OFF_VTE);
  f32x16 acc[2][2]; float ss[2];
  gemm_core<true>(W + (size_t)nt * 128 * 128, 128, Z + (size_t)mt * 128 * 2048 + 256, 2048, 128, sP, sQ, acc, ss);
#pragma unroll
  for (int ni = 0; ni < 2; ++ni) {
    const float rs = rsqrtf(swapsum(ss[ni]) * (1.f / 128.f) + RMS_EPS);
    const int m = mt * 128 + wn * 64 + ni * 32 + r, b = m / TB, t = m % TB;
#pragma unroll
    for (int mi = 0; mi < 2; ++mi) {
      const int gt = (nt * 128 + wm * 64 + mi * 32) >> 5, hd = gt >> 2, part = gt & 3;
      if (part < 2) {
        u16* dst = Kn + ((size_t)(b * 8 + hd) * TB + t) * 64 + part * 32 + 4 * h;
#pragma unroll
        for (int g = 0; g < 4; ++g) {
          uint2 w = {pk2(acc[mi][ni][4 * g] * rs, acc[mi][ni][4 * g + 1] * rs), pk2(acc[mi][ni][4 * g + 2] * rs, acc[mi][ni][4 * g + 3] * rs)};
          *(uint2*)(dst + 8 * g) = w;
        }
      } else {
        u16* dst = Vt + ((size_t)(b * 8 + hd) * 64 + (part - 2) * 32) * TB + t;
#pragma unroll
        for (int i = 0; i < 16; ++i) dst[(size_t)crow(i, h) * TB] = f2bf(acc[mi][ni][i] * rs);
      }
    }
  }
}
DI void krope_item(const Params& p, int it) {
  const int tid = ltid();
  const int m = it * 16 + (tid >> 4), f = tid & 15, blk = f >> 3, fi = f & 7;
  const int t = m % TB;
  const u16* src = (const u16*)(p.ws + OFF_ZE) + (size_t)m * 2048 + 384 + 16 * blk + fi;
  u16* dst = (u16*)(p.ws + OFF_KR) + (size_t)m * 32 + 16 * blk + fi;
  float x1 = bf2f(src[0]), x2 = bf2f(src[8]);
  if (t >= CTX) {
    const int pos = t - CTX;
    const float ang = (float)(blk ? (pos & 63) : (pos >> 6)) * exp2f(-(float)fi * 1.6609640474436813f);
    const float c = __cosf(ang), s = __sinf(ang);
    const float y1 = x1 * c - x2 * s, y2 = x2 * c + x1 * s;
    x1 = y1; x2 = y2;
  }
  dst[0] = f2bf(x1); dst[8] = f2bf(x2);
}

constexpr int LRU_SU = 0, LRU_SA = 64 * 72 * 2, LRU_SUU = LRU_SA + 2 * 64 * 64 * 4, LRU_SMEM = LRU_SUU + 2 * 64 * 64 * 2;
template <int PASS>
DI void lru_item(const Params& p, int li, int it, char* smem) {
  const int tid = ltid(), lane = tid & 63, wid = tid >> 6, r = lane & 31, h = lane >> 5;
  const int n = it & 7, j = (it >> 3) % NCH, b = it / (8 * NCH);
  const int t0 = j * 64, seg_lo = j < 4 ? 0 : CTX, seg_hi = j < 4 ? CTX : TB;
  u16* sU = (u16*)(smem + LRU_SU);
  float* sA = (float*)(smem + LRU_SA);
  u16* sUU = (u16*)(smem + LRU_SUU);
  const u16* zE = (const u16*)(p.ws + OFF_ZE);
  const int mi = wid >> 1, ni = wid & 1;
  const int cc = ni * 32 + r, gcw = n * 64 + cc;
  const int cconv = tid & 63, tg = tid >> 6, gcc = n * 64 + cconv;
  const u16* zcol = zE + (size_t)b * TB * 2048 + 928 + gcc;
  const int tb = t0 + tg * 16;
  float xv[19];
#pragma unroll
  for (int q = 0; q < 19; ++q) {
    const int t = tb - 2 + q; const bool ok = (t >= seg_lo) && (t < seg_hi);
    const float v = bf2f(zcol[(size_t)(ok ? t : seg_lo) * 2048]);
    xv[q] = ok ? v : 0.f;
  }
  const float* cw = p.conv_w + (size_t)li * 4 * 512 + gcc;
  const float w0 = cw[0], w1 = cw[512], w2 = cw[1024], w3 = cw[1536], cb = p.conv_b[li * 512 + gcc];
  const u16* WA = (const u16*)(p.ws + OFF_WA) + ((size_t)(li * 2) * 8 + n) * 4096 + (ni * 32 + r) * 64 + 8 * h;
  const u16* WX = (const u16*)(p.ws + OFF_WX) + ((size_t)(li * 2) * 8 + n) * 4096 + (ni * 32 + r) * 64 + 8 * h;
  bf16x8 wfa[2][4], wfx[2][4];
#pragma unroll
  for (int d = 0; d < 2; ++d)
#pragma unroll
    for (int s = 0; s < 4; ++s) { wfa[d][s] = *(const bf16x8*)(WA + (size_t)d * 8 * 4096 + 16 * s); wfx[d][s] = *(const bf16x8*)(WX + (size_t)d * 8 * 4096 + 16 * s); }
  float pba[2], pbx[2], plam[2];
#pragma unroll
  for (int d = 0; d < 2; ++d) { const int pi = (li * 2 + d) * 512 + gcw; pba[d] = p.ba[pi]; pbx[d] = p.bx[pi]; plam[d] = p.lam[pi]; }
  float* aggA = (float*)(p.ws + OFF_AGGA);
  float* aggH = (float*)(p.ws + OFF_AGGH);
  const int dsc = (tid >> 6) & 1, csc = tid & 63;
  const size_t osc = ((size_t)(b * NCH + j) * 2 + dsc) * 512 + n * 64 + csc;
  float carry = 0.f; u16 gq[16];
  if (PASS == 3) {
    carry = aggH[osc];
#pragma unroll
    for (int i = 0; i < 16; ++i) { const int idx = tid + 256 * i, t = idx >> 6, c = idx & 63; gq[i] = zE[((size_t)b * TB + t0 + t) * 2048 + 1440 + n * 64 + c]; }
  }
  {
#pragma unroll
    for (int tt = 0; tt < 16; ++tt) {
      const float u = w0 * xv[tt] + w1 * xv[tt + 1] + w2 * xv[tt + 2] + w3 * xv[tt + 3] + cb;
      sU[(tg * 16 + tt) * 72 + cconv] = f2bf(u);
    }
  }
  __syncthreads();
  {
    f32x16 acc[2][2];
#pragma unroll
    for (int d = 0; d < 2; ++d)
#pragma unroll
      for (int q = 0; q < 2; ++q)
#pragma unroll
        for (int i = 0; i < 16; ++i) acc[d][q][i] = 0.f;
#pragma unroll
    for (int s = 0; s < 4; ++s) {
      const bf16x8 af = *(const bf16x8*)(sU + (mi * 32 + r) * 72 + 16 * s + 8 * h);
#pragma unroll
      for (int d = 0; d < 2; ++d) { acc[d][0] = mfma32(af, wfa[d][s], acc[d][0]); acc[d][1] = mfma32(af, wfx[d][s], acc[d][1]); }
    }
#pragma unroll
    for (int d = 0; d < 2; ++d) {
      const float ba = pba[d], bx = pbx[d], lam = plam[d];
      const float sp = log1pf(__expf(-lam));
#pragma unroll
      for (int i = 0; i < 16; ++i) {
        const int tl = mi * 32 + crow(i, h);
        const float rr = sigmoidf(acc[d][0][i] + ba), ii = sigmoidf(acc[d][1][i] + bx);
        const float la = -8.f * rr * sp;
        const float a = __expf(la);
        const float x2 = 2.f * la;
        const float ser = -x2 * (1.f + x2 * (0.5f + x2 * (0.16666667f + x2 * (0.041666668f + x2 * (0.0083333338f + x2 * 0.0013888889f)))));
        const float om = x2 > -0.25f ? ser : 1.f - a * a;
        const float mult = __builtin_amdgcn_sqrtf(fmaxf(om, 0.f));
        const float uval = bf2f(sU[tl * 72 + cc]);
        sA[(d * 64 + tl) * 64 + cc] = a;
        sUU[(d * 64 + tl) * 64 + cc] = f2bf(mult * ii * uval);
      }
    }
  }
  __syncthreads();
  if (tid < 128) {
    const int d = tid >> 6, c = tid & 63, gc = n * 64 + c;
    const int tf = d ? 63 : 0, ts = d ? -64 : 64;
    float* pa = sA + (d * 64 + tf) * 64 + c;
    const u16* pu = sUU + (d * 64 + tf) * 64 + c;
    const size_t o = ((size_t)(b * NCH + j) * 2 + d) * 512 + gc;
    float hh = PASS == 1 ? 0.f : carry;
    float A = 1.f;
#pragma unroll
    for (int blk = 0; blk < 2; ++blk) {
      float av[32], uv[32];
#pragma unroll
      for (int k = 0; k < 32; ++k) { av[k] = pa[(blk * 32 + k) * ts]; uv[k] = bf2f(pu[(blk * 32 + k) * ts]); }
#pragma unroll
      for (int k = 0; k < 32; ++k) { A *= av[k]; hh = av[k] * hh + uv[k]; av[k] = hh; }
      if (PASS == 3) {
#pragma unroll
        for (int k = 0; k < 32; ++k) pa[(blk * 32 + k) * ts] = av[k];
      }
    }
    if (PASS == 1) { aggA[o] = A; aggH[o] = hh; }
  }
  if (PASS == 3) {
    __syncthreads();
    u16* mix = (u16*)(p.ws + OFF_H);
#pragma unroll
    for (int i = 0; i < 16; ++i) {
      const int idx = tid + 256 * i, t = idx >> 6, c = idx & 63, gc = n * 64 + c;
      const float rsum = sA[t * 64 + c] + sA[(64 + t) * 64 + c];
      const size_t m = (size_t)b * TB + t0 + t;
      const float g = bf2f(gq[i]);
      mix[m * 1024 + 512 + gc] = f2bf(rsum * silu(g));
    }
  }
  __syncthreads();
}

DI void phase_e2(const Params& p, int li, char* smem) {
  constexpr int N_LRU = NB * NCH * 8, N_Q = (M / 128) * 6, N_KV = (M / 128) * 8, N_KR = M / 16;
  for (int it = lbid(); it < N_LRU + N_Q + N_KV + N_KR; it += VGRID) {
    int q = it;
    if (q < N_LRU) { lru_item<1>(p, li, q, smem); continue; }
    q -= N_LRU;
    if (q < N_Q) { qproj_tile(p, li, q / 6, q % 6, smem); continue; }
    q -= N_Q;
    if (q < N_KV) { kvproj_tile(p, li, q >> 3, q & 7, smem); continue; }
    q -= N_KV;
    krope_item(p, q);
  }
}

template <int MODE>
DI void attn_item(const Params& p, int li, int it, char* smem) {
  constexpr int DQK = MODE == 0 ? 96 : 64, KLD = DQK + 8, KS = DQK / 16, VLD = 68;
  constexpr int SK_E = 64 * KLD, SV_E = 64 * VLD;
  u16* sK = (u16*)smem;
  u16* sV = sK + 2 * SK_E;
  float* sBias = (float*)(sV + 2 * SV_E);
  const int tid = ltid(), lane = tid & 63, wid = tid >> 6, r = lane & 31, h = lane >> 5;

  int b, hd, bh, tq, nsteps;
  int qrow = 0, qcol = 0, rsA = 0, rsW = 0;
  const u16* Qp;
  if (MODE == 0) {
    int qb;
    if (it < 2048) { const int ch = it >> 9, w = it & 511; bh = ch * 8 + (w & 7); qb = w >> 3; }
    else { const int jx = it - 2048; bh = jx >> 1; qb = 64 + (jx & 1); }
    b = bh >> 3; hd = bh & 7;
    int tqb;
    if (qb < 64) { tqb = CTX + qb * 128; nsteps = NCH; } else { tqb = (qb - 64) * 128; nsteps = CTX / 64; }
    tq = tqb + wid * 32 + r;
    Qp = (const u16*)(p.ws + OFF_Q) + ((size_t)bh * TB + tq) * 96 + 8 * h;
  } else {
    if (it < 4096) {
      const int ch = it >> 9, w = it & 511;
      bh = ch * 8 + (w & 7); const int rp = w >> 3;
      const int r0 = 2 * rp;
      qrow = r0 + (wid >> 1); qcol = (wid & 1) * 32 + r;
      tq = CTX + qrow * 64 + qcol;
      rsA = min(max(r0 - 4, 0), 120);
      const int rsB = min(max(r0 - 3, 0), 120);
      rsW = (wid >> 1) ? rsB : rsA;
      nsteps = 4 + rsB + 8 - rsA;
    } else {
      const int jx = it - 4096;
      bh = jx >> 1; tq = (jx & 1) * 128 + wid * 32 + r; nsteps = 4;
    }
    b = bh >> 4; hd = bh & 15;
    Qp = (const u16*)(p.ws + OFF_ZO) + ((size_t)b * TB + tq) * 3072 + hd * 64 + 8 * h;
    const float* rpb = p.rpb + ((size_t)li * 16 + hd) * 465;
    for (int e = tid; e < 576; e += 256) { const int k = e - 48; sBias[e] = (k >= 0 && k < 465) ? rpb[k] * LOG2E : 0.f; }
  }
  bf16x8 qf[KS];
#pragma unroll
  for (int s = 0; s < KS; ++s) qf[s] = *(const bf16x8*)(Qp + 16 * s);

  const int lkey = tid >> 3, lc8 = (tid & 7) * 8;
  const int rkey = tid >> 2, rc8 = (tid & 3) * 8;
  uint4 aK0, aK1, aV0, aV1, aR, bK0, bK1, bV0, bV1, bR;
  const u16 *gK, *gV, *gR = nullptr;
  size_t kstride;
  if (MODE == 0) {
    gK = (const u16*)(p.ws + OFF_KN) + ((size_t)bh * TB + lkey) * 64 + lc8; kstride = 64;
    gR = (const u16*)(p.ws + OFF_KR) + ((size_t)b * TB + rkey) * 32 + rc8;
    gV = (const u16*)(p.ws + OFF_VTE) + ((size_t)bh * 64 + lkey) * TB + lc8;
  } else {
    gK = (const u16*)(p.ws + OFF_ZO) + ((size_t)b * TB + lkey) * 3072 + 1024 + hd * 64 + lc8; kstride = 3072;
    gV = (const u16*)(p.ws + OFF_VTO) + ((size_t)bh * 64 + lkey) * TB + lc8;
  }
  auto tile_t0 = [&](int st) -> int { if (MODE == 0) return st * 64; return st < 4 ? st * 64 : CTX + (rsA + st - 4) * 64; };
#define ATT_LOAD(X, st_) do { const int t0_ = tile_t0(st_); \
    X##K0 = *(const uint4*)(gK + (size_t)t0_ * kstride); X##K1 = *(const uint4*)(gK + (size_t)(t0_ + 32) * kstride); \
    if (MODE == 0) X##R = *(const uint4*)(gR + (size_t)t0_ * 32); \
    X##V0 = *(const uint4*)(gV + t0_); X##V1 = *(const uint4*)(gV + (size_t)32 * TB + t0_); } while (0)
#define ATT_STORE(X, sKb_, sVb_) do { \
    *(uint4*)((sKb_) + lkey * KLD + lc8) = X##K0; *(uint4*)((sKb_) + (lkey + 32) * KLD + lc8) = X##K1; \
    if (MODE == 0) *(uint4*)((sKb_) + rkey * KLD + 64 + rc8) = X##R; \
    *(uint2*)((sVb_) + lkey * VLD + lc8) = make_uint2(X##V0.x, X##V0.y); *(uint2*)((sVb_) + lkey * VLD + lc8 + 4) = make_uint2(X##V0.z, X##V0.w); \
    *(uint2*)((sVb_) + (lkey + 32) * VLD + lc8) = make_uint2(X##V1.x, X##V1.y); *(uint2*)((sVb_) + (lkey + 32) * VLD + lc8 + 4) = make_uint2(X##V1.z, X##V1.w); } while (0)
  f32x16 O0, O1;
#pragma unroll
  for (int i = 0; i < 16; ++i) { O0[i] = 0.f; O1[i] = 0.f; }
  float m_run = 0.f, l_run = 0.f;
  f32x16 NEGM;
#pragma unroll
  for (int i = 0; i < 16; ++i) NEGM[i] = 0.f;
  constexpr float THR = 8.f;
  auto compute = [&](const u16* sKb, const u16* sVb, int st) {
    bool active = st < nsteps;
    int krow = 0;
    if (MODE == 1 && st >= 4) { krow = rsA + st - 4; active = active && (krow >= rsW) && (krow < rsW + 8); }
    if (!active) return;
    f32x16 S0 = NEGM, S1 = NEGM;
    bf16x8 kfa[KS], kfb[KS];
#pragma unroll
    for (int s = 0; s < KS; ++s) {
      kfa[s] = *(const bf16x8*)(sKb + r * KLD + 16 * s + 8 * h);
      kfb[s] = *(const bf16x8*)(sKb + (32 + r) * KLD + 16 * s + 8 * h);
    }
#pragma unroll
    for (int s = 0; s < KS; ++s) { S0 = mfma32(kfa[s], qf[s], S0); S1 = mfma32(kfb[s], qf[s], S1); }
    const bool local = MODE == 1 && st >= 4;
    const int qt = qcol >> 5;
    if (local) {
      const int dr = krow - qrow + 7;
      const int cs = min(max(qcol - 8, 0), 48);
      const float* tb = sBias + 48 + dr * 31 - qcol + 15;
      if (qt == 0) {
#pragma unroll
        for (int i = 0; i < 16; ++i) { const int kc = crow(i, h); S0[i] = (unsigned)(kc - cs) < 16u ? S0[i] + tb[kc] : -1e30f; }
#pragma unroll
        for (int i = 0; i < 4; ++i) { const int kc = 32 + crow(i, h); S1[i] = (unsigned)(kc - cs) < 16u ? S1[i] + tb[kc] : -1e30f; }
#pragma unroll
        for (int i = 4; i < 16; ++i) S1[i] = -1e30f;
      } else {
#pragma unroll
        for (int i = 0; i < 12; ++i) S0[i] = -1e30f;
#pragma unroll
        for (int i = 12; i < 16; ++i) { const int kc = crow(i, h); S0[i] = (unsigned)(kc - cs) < 16u ? S0[i] + tb[kc] : -1e30f; }
#pragma unroll
        for (int i = 0; i < 16; ++i) { const int kc = 32 + crow(i, h); S1[i] = (unsigned)(kc - cs) < 16u ? S1[i] + tb[kc] : -1e30f; }
      }
    }
    bool ex = false;
#pragma unroll
    for (int i = 0; i < 16; ++i) ex |= (S0[i] > THR) | (S1[i] > THR);
    if (__any(ex) || st == 0) {
      float pm = fmaxf(S0[0], S1[0]);
#pragma unroll
      for (int i = 1; i < 16; ++i) pm = fmaxf(pm, fmaxf(S0[i], S1[i]));
      pm = swapmax(pm);
      const bool first = st == 0;
      const float delta = first ? pm : fmaxf(pm, 0.f);
      const float al = first ? 1.f : __builtin_amdgcn_exp2f(-delta);
      m_run += delta; l_run *= al;
#pragma unroll
      for (int i = 0; i < 16; ++i) { O0[i] *= al; O1[i] *= al; S0[i] -= delta; S1[i] -= delta; NEGM[i] = -m_run; }
    }
#define VREAD(ds_) const u16* vp = sVb + (32 * (ds_) + r) * VLD + 4 * h; \
      const s16x4 a0 = *(const s16x4*)(vp), a1 = *(const s16x4*)(vp + 8), a2 = *(const s16x4*)(vp + 16), a3 = *(const s16x4*)(vp + 24); \
      const s16x4 a4 = *(const s16x4*)(vp + 32), a5 = *(const s16x4*)(vp + 40), a6 = *(const s16x4*)(vp + 48), a7 = *(const s16x4*)(vp + 56)
#define VCAT(x, y) __builtin_shufflevector(x, y, 0, 1, 2, 3, 4, 5, 6, 7)
    if (local && qt == 0) {
      float ps = 0.f;
#pragma unroll
      for (int i = 0; i < 16; ++i) { S0[i] = __builtin_amdgcn_exp2f(S0[i]); ps += S0[i]; }
#pragma unroll
      for (int i = 0; i < 4; ++i) { S1[i] = __builtin_amdgcn_exp2f(S1[i]); ps += S1[i]; }
      l_run += ps;
      const bf16x8 p00 = pack8(S0[0], S0[1], S0[2], S0[3], S0[4], S0[5], S0[6], S0[7]);
      const bf16x8 p01 = pack8(S0[8], S0[9], S0[10], S0[11], S0[12], S0[13], S0[14], S0[15]);
      const bf16x8 p10 = pack8(S1[0], S1[1], S1[2], S1[3], 0.f, 0.f, 0.f, 0.f);
      { VREAD(0); (void)a6; (void)a7; O0 = mfma32(VCAT(a0, a1), p00, O0); O0 = mfma32(VCAT(a2, a3), p01, O0); O0 = mfma32(VCAT(a4, a5), p10, O0); }
      { VREAD(1); (void)a6; (void)a7; O1 = mfma32(VCAT(a0, a1), p00, O1); O1 = mfma32(VCAT(a2, a3), p01, O1); O1 = mfma32(VCAT(a4, a5), p10, O1); }
      return;
    }
    if (local && qt == 1) {
      float ps = 0.f;
#pragma unroll
      for (int i = 12; i < 16; ++i) { S0[i] = __builtin_amdgcn_exp2f(S0[i]); ps += S0[i]; }
#pragma unroll
      for (int i = 0; i < 16; ++i) { S1[i] = __builtin_amdgcn_exp2f(S1[i]); ps += S1[i]; }
      l_run += ps;
      const bf16x8 p01 = pack8(0.f, 0.f, 0.f, 0.f, S0[12], S0[13], S0[14], S0[15]);
      const bf16x8 p10 = pack8(S1[0], S1[1], S1[2], S1[3], S1[4], S1[5], S1[6], S1[7]);
      const bf16x8 p11 = pack8(S1[8], S1[9], S1[10], S1[11], S1[12], S1[13], S1[14], S1[15]);
      { VREAD(0); (void)a0; (void)a1; O0 = mfma32(VCAT(a2, a3), p01, O0); O0 = mfma32(VCAT(a4, a5), p10, O0); O0 = mfma32(VCAT(a6, a7), p11, O0); }
      { VREAD(1); (void)a0; (void)a1; O1 = mfma32(VCAT(a2, a3), p01, O1); O1 = mfma32(VCAT(a4, a5), p10, O1); O1 = mfma32(VCAT(a6, a7), p11, O1); }
      return;
    }
#undef VREAD
#undef VCAT
    float ps = 0.f;
#pragma unroll
    for (int i = 0; i < 16; ++i) { S0[i] = __builtin_amdgcn_exp2f(S0[i]); S1[i] = __builtin_amdgcn_exp2f(S1[i]); ps += S0[i] + S1[i]; }
    l_run += ps;
    const bf16x8 p00 = pack8(S0[0], S0[1], S0[2], S0[3], S0[4], S0[5], S0[6], S0[7]);
    const bf16x8 p01 = pack8(S0[8], S0[9], S0[10], S0[11], S0[12], S0[13], S0[14], S0[15]);
    const bf16x8 p10 = pack8(S1[0], S1[1], S1[2], S1[3], S1[4], S1[5], S1[6], S1[7]);
    const bf16x8 p11 = pack8(S1[8], S1[9], S1[10], S1[11], S1[12], S1[13], S1[14], S1[15]);
#pragma unroll
    for (int ds = 0; ds < 2; ++ds) {
      const u16* vp = sVb + (32 * ds + r) * VLD + 4 * h;
      const s16x4 a0 = *(const s16x4*)(vp), a1 = *(const s16x4*)(vp + 8), a2 = *(const s16x4*)(vp + 16), a3 = *(const s16x4*)(vp + 24);
      const s16x4 a4 = *(const s16x4*)(vp + 32), a5 = *(const s16x4*)(vp + 40), a6 = *(const s16x4*)(vp + 48), a7 = *(const s16x4*)(vp + 56);
      const bf16x8 v00 = __builtin_shufflevector(a0, a1, 0, 1, 2, 3, 4, 5, 6, 7), v01 = __builtin_shufflevector(a2, a3, 0, 1, 2, 3, 4, 5, 6, 7);
      const bf16x8 v10 = __builtin_shufflevector(a4, a5, 0, 1, 2, 3, 4, 5, 6, 7), v11 = __builtin_shufflevector(a6, a7, 0, 1, 2, 3, 4, 5, 6, 7);
      if (ds == 0) { O0 = mfma32(v00, p00, O0); O0 = mfma32(v01, p01, O0); O0 = mfma32(v10, p10, O0); O0 = mfma32(v11, p11, O0); }
      else         { O1 = mfma32(v00, p00, O1); O1 = mfma32(v01, p01, O1); O1 = mfma32(v10, p10, O1); O1 = mfma32(v11, p11, O1); }
    }
  };
  const int nlast = nsteps - 1, npad = (MODE == 1 && it < 4096) ? 14 : ((nsteps + 1) & ~1);
  ATT_LOAD(a, 0);
  ATT_LOAD(b, min(1, nlast));
  for (int st = 0; st < npad; st += 2) {
    ATT_STORE(a, sK, sV);
    ATT_LOAD(a, min(st + 2, nlast));
    __syncthreads();
    compute(sK, sV, st);
    ATT_STORE(b, sK + SK_E, sV + SV_E);
    ATT_LOAD(b, min(st + 3, nlast));
    __syncthreads();
    compute(sK + SK_E, sV + SV_E, st + 1);
  }
#undef ATT_LOAD
#undef ATT_STORE
  {
    const float inv = 1.f / swapsum(l_run);
    const size_t mrow = (size_t)b * TB + tq;
    const u16* gp; u16* op = (u16*)(p.ws + OFF_H) + mrow * 1024 + hd * 64 + 4 * h;
    if (MODE == 0) gp = (const u16*)(p.ws + OFF_ZE) + mrow * 2048 + 416 + hd * 64 + 4 * h;
    else gp = (const u16*)(p.ws + OFF_ZO) + mrow * 3072 + 2048 + hd * 64 + 4 * h;
#pragma unroll
    for (int ds = 0; ds < 2; ++ds)
#pragma unroll
      for (int g = 0; g < 4; ++g) {
        const uint2 gv = *(const uint2*)(gp + 32 * ds + 8 * g);
        const float o0 = (ds ? O1[4 * g] : O0[4 * g]) * inv, o1 = (ds ? O1[4 * g + 1] : O0[4 * g + 1]) * inv;
        const float o2 = (ds ? O1[4 * g + 2] : O0[4 * g + 2]) * inv, o3 = (ds ? O1[4 * g + 3] : O0[4 * g + 3]) * inv;
        uint2 w = {pk2(o0 * silu(bflo(gv.x)), o1 * silu(bfhi(gv.x))), pk2(o2 * silu(bflo(gv.y)), o3 * silu(bfhi(gv.y)))};
        *(uint2*)(op + 32 * ds + 8 * g) = w;
      }
  }
  __syncthreads();
}


DI void mla_item8(const Params& p, int li, int it, char* smem) {
  constexpr int KLD = 104, KS = 6, VLD = 68, SK_E = 64 * KLD, SV_E = 64 * VLD;
  u16* sK = (u16*)smem;
  u16* sV = sK + 4 * SK_E;
  int tid = threadIdx.x; asm volatile("" : "+v"(tid));
  const int lane = tid & 63, wid = tid >> 6, r = lane & 31, h = lane >> 5;
  int bh, tqb, nsteps;
  if (it < 1024) { const int ch = it >> 8, w = it & 255; bh = ch * 8 + (w & 7); tqb = CTX + (w >> 3) * 256; nsteps = NCH; }
  else { bh = it - 1024; tqb = 0; nsteps = CTX / 64; }
  const int b = bh >> 3, hd = bh & 7;
  const int tq = tqb + wid * 32 + r;
  const u16* Qp = (const u16*)(p.ws + OFF_Q) + ((size_t)bh * TB + tq) * 96 + 8 * h;
  bf16x8 qf[KS];
#pragma unroll
  for (int s = 0; s < KS; ++s) qf[s] = *(const bf16x8*)(Qp + 16 * s);
  const int lkey = tid >> 3, lc8 = (tid & 7) * 8;
  const int rkey = tid >> 2, rc8 = (tid & 3) * 8;
  const u16* gK = (const u16*)(p.ws + OFF_KN) + ((size_t)bh * TB + lkey) * 64 + lc8;
  const u16* gR = (const u16*)(p.ws + OFF_KR) + ((size_t)b * TB + rkey) * 32 + rc8;
  const u16* gV = (const u16*)(p.ws + OFF_VTE) + ((size_t)bh * 64 + lkey) * TB + lc8;
  const int nlast = nsteps - 1;
  uint4 aK0, aK1, aR, aV0, aV1, bK0, bK1, bR, bV0, bV1;
#define LD_K(X, tile_) do { const int t0_ = min((tile_), nlast) * 64; \
    X##K0 = *(const uint4*)(gK + (size_t)t0_ * 64); if (wid < 4) X##R = *(const uint4*)(gR + (size_t)t0_ * 32); } while (0)
#define LD_V(X, tile_) do { const int t0_ = min((tile_), nlast) * 64; X##V0 = *(const uint4*)(gV + t0_); } while (0)
#define ST_K(X, kb_) do { u16* d_ = sK + (kb_) * SK_E; \
    *(uint4*)(d_ + lkey * KLD + lc8) = X##K0; if (wid < 4) *(uint4*)(d_ + rkey * KLD + 64 + rc8) = X##R; } while (0)
#define ST_V(X, vb_) do { u16* d_ = sV + (vb_) * SV_E; \
    *(uint2*)(d_ + lkey * VLD + lc8) = make_uint2(X##V0.x, X##V0.y); *(uint2*)(d_ + lkey * VLD + lc8 + 4) = make_uint2(X##V0.z, X##V0.w); } while (0)
  f32x16 O0, O1, NEGM;
#pragma unroll
  for (int i = 0; i < 16; ++i) { O0[i] = 0.f; O1[i] = 0.f; NEGM[i] = 0.f; }
  float m_run = 0.f, l_run = 0.f;
  constexpr float THR = 8.f;
  auto qk = [&](const u16* kb, f32x16& A0, f32x16& A1) {
    A0 = NEGM; A1 = NEGM;
#pragma unroll
    for (int s = 0; s < KS; ++s) {
      const bf16x8 k0 = *(const bf16x8*)(kb + r * KLD + 16 * s + 8 * h);
      const bf16x8 k1 = *(const bf16x8*)(kb + (32 + r) * KLD + 16 * s + 8 * h);
      A0 = mfma32(k0, qf[s], A0); A1 = mfma32(k1, qf[s], A1);
    }
  };
  auto check = [&](f32x16& A0, f32x16& A1, const bool first) {
    bool ex = false;
#pragma unroll
    for (int i = 0; i < 16; ++i) ex |= (A0[i] > THR) | (A1[i] > THR);
    if (__any(ex) || first) {
      float pm = fmaxf(A0[0], A1[0]);
#pragma unroll
      for (int i = 1; i < 16; ++i) pm = fmaxf(pm, fmaxf(A0[i], A1[i]));
      pm = swapmax(pm);
      const float delta = first ? pm : fmaxf(pm, 0.f);
      const float al = first ? 1.f : __builtin_amdgcn_exp2f(-delta);
      m_run += delta; l_run *= al;
#pragma unroll
      for (int i = 0; i < 16; ++i) { O0[i] *= al; O1[i] *= al; A0[i] -= delta; A1[i] -= delta; NEGM[i] -= delta; }
    }
  };
  auto smpv = [&](f32x16& A0, f32x16& A1, const u16* vb) {
    float ps = 0.f;
#pragma unroll
    for (int i = 0; i < 16; ++i) { A0[i] = __builtin_amdgcn_exp2f(A0[i]); A1[i] = __builtin_amdgcn_exp2f(A1[i]); ps += A0[i] + A1[i]; }
    l_run += ps;
    const bf16x8 p00 = pack8(A0[0], A0[1], A0[2], A0[3], A0[4], A0[5], A0[6], A0[7]);
    const bf16x8 p01 = pack8(A0[8], A0[9], A0[10], A0[11], A0[12], A0[13], A0[14], A0[15]);
    const bf16x8 p10 = pack8(A1[0], A1[1], A1[2], A1[3], A1[4], A1[5], A1[6], A1[7]);
    const bf16x8 p11 = pack8(A1[8], A1[9], A1[10], A1[11], A1[12], A1[13], A1[14], A1[15]);
#pragma unroll
    for (int ds = 0; ds < 2; ++ds) {
      const u16* vp = vb + (32 * ds + r) * VLD + 4 * h;
      const s16x4 a0 = *(const s16x4*)(vp), a1 = *(const s16x4*)(vp + 8), a2 = *(const s16x4*)(vp + 16), a3 = *(const s16x4*)(vp + 24);
      const s16x4 a4 = *(const s16x4*)(vp + 32), a5 = *(const s16x4*)(vp + 40), a6 = *(const s16x4*)(vp + 48), a7 = *(const s16x4*)(vp + 56);
      const bf16x8 v00 = __builtin_shufflevector(a0, a1, 0, 1, 2, 3, 4, 5, 6, 7), v01 = __builtin_shufflevector(a2, a3, 0, 1, 2, 3, 4, 5, 6, 7);
      const bf16x8 v10 = __builtin_shufflevector(a4, a5, 0, 1, 2, 3, 4, 5, 6, 7), v11 = __builtin_shufflevector(a6, a7, 0, 1, 2, 3, 4, 5, 6, 7);
      if (ds == 0) { O0 = mfma32(v00, p00, O0); O0 = mfma32(v01, p01, O0); O0 = mfma32(v10, p10, O0); O0 = mfma32(v11, p11, O0); }
      else         { O1 = mfma32(v00, p00, O1); O1 = mfma32(v01, p01, O1); O1 = mfma32(v10, p10, O1); O1 = mfma32(v11, p11, O1); }
    }
  };
  LD_K(a, 0); LD_V(a, 0); LD_K(b, 1); LD_V(b, 1);
  ST_K(a, 0); ST_V(a, 0); ST_K(b, 1); ST_V(b, 1);
  LD_K(a, 2);
  ST_K(a, 2);
  LD_K(a, 3); LD_V(a, 2); LD_K(b, 4); LD_V(b, 3);
  __syncthreads();
  f32x16 Sc0, Sc1, Sn0, Sn1;
  qk(sK, Sc0, Sc1);
  check(Sc0, Sc1, true);
  __syncthreads();
  for (int j = 0; j < nsteps; j += 4) {
    ST_K(a, 3); ST_K(b, 0); ST_V(a, 2); ST_V(b, 3);
    LD_K(a, j + 5); LD_V(a, j + 4); LD_K(b, j + 6); LD_V(b, j + 5);
    qk(sK + 1 * SK_E, Sn0, Sn1);  smpv(Sc0, Sc1, sV + 0 * SV_E);  check(Sn0, Sn1, false);
    qk(sK + 2 * SK_E, Sc0, Sc1);  smpv(Sn0, Sn1, sV + 1 * SV_E);  check(Sc0, Sc1, false);
    __syncthreads();
    ST_K(a, 1); ST_K(b, 2); ST_V(a, 0); ST_V(b, 1);
    LD_K(a, j + 7); LD_V(a, j + 6); LD_K(b, j + 8); LD_V(b, j + 7);
    qk(sK + 3 * SK_E, Sn0, Sn1);  smpv(Sc0, Sc1, sV + 2 * SV_E);  check(Sn0, Sn1, false);
    qk(sK + 0 * SK_E, Sc0, Sc1);  smpv(Sn0, Sn1, sV + 3 * SV_E);  check(Sc0, Sc1, false);
    __syncthreads();
  }
#undef LD_K
#undef LD_V
#undef ST_K
#undef ST_V
  {
    const float inv = 1.f / swapsum(l_run);
    const size_t mrow = (size_t)b * TB + tq;
    u16* op = (u16*)(p.ws + OFF_H) + mrow * 1024 + hd * 64 + 4 * h;
    const u16* gp = (const u16*)(p.ws + OFF_ZE) + mrow * 2048 + 416 + hd * 64 + 4 * h;
#pragma unroll
    for (int ds = 0; ds < 2; ++ds)
#pragma unroll
      for (int g = 0; g < 4; ++g) {
        const uint2 gv = *(const uint2*)(gp + 32 * ds + 8 * g);
        const float o0 = (ds ? O1[4 * g] : O0[4 * g]) * inv, o1 = (ds ? O1[4 * g + 1] : O0[4 * g + 1]) * inv;
        const float o2 = (ds ? O1[4 * g + 2] : O0[4 * g + 2]) * inv, o3 = (ds ? O1[4 * g + 3] : O0[4 * g + 3]) * inv;
        uint2 w = {pk2(o0 * silu(bflo(gv.x)), o1 * silu(bfhi(gv.x))), pk2(o2 * silu(bflo(gv.y)), o3 * silu(bfhi(gv.y)))};
        *(uint2*)(op + 32 * ds + 8 * g) = w;
      }
  }
  __syncthreads();
}

DI void phase_e3(const Params& p, int li, char* smem) {
  constexpr int N_MLA = 2048 + 64, N_LRU = NB * NCH * 8;
  const bool lru_first = lbid() >= (VGRID >> 1);
  for (int stage = 0; stage < 2; ++stage) {
    if ((stage == 0) == lru_first) {
      for (int it = lbid(); it < N_LRU; it += VGRID) lru_item<3>(p, li, it, smem);
    } else {
      for (int it = pbid(); it < 1024 + 32; it += (int)gridDim.x) mla_item8(p, li, it, smem - lhalf() * 65536);
    }
  }
}
DI void phase_na(const Params& p, int li, int nitems, char* smem) {
  for (int it = lbid(); it < nitems; it += VGRID) attn_item<1>(p, li, it, smem);
}


namespace pg8 {
#define PG8_LAS __attribute__((address_space(3)))
typedef unsigned short bf16_t;
typedef short bf16x8 __attribute__((ext_vector_type(8)));
typedef float f32x4 __attribute__((ext_vector_type(4)));
typedef unsigned u32x4 __attribute__((ext_vector_type(4)));
constexpr int BM = 256, BK = 64, HALF = 128, HTB = HALF * BK * 2  , STAGE_BYTES = 8 * HTB, NXCD = 8, WGM = 8;

__host__ __device__ __forceinline__ int lds_byte(int r, int c) { const int st = (r >> 4) * 2 + (c >> 5), rr = r & 15, cc = c & 31, ob = rr * 64 + cc * 2; return st * 1024 + (ob ^ (((ob >> 9) & 1) << 5)); }
__host__ __device__ __forceinline__ void stage_rc(int b, int& R, int& C) { const int st = b / 1024, sb = b % 1024, swz = sb ^ (((sb >> 9) & 1) << 5); R = (st >> 1) * 16 + swz / 64; C = (st & 1) * 32 + (swz % 64) / 2; }
__host__ __device__ __forceinline__ int perm32(int rho) { const int n = rho >> 4, i = rho & 15; return 8 * (i >> 2) + 4 * n + (i & 3); }

struct Unit { int pm, pn, kind; };
struct Gemm { const bf16_t* A; const bf16_t* Bt; int M, N, K; };
struct StaticOrder {
    int nM, nN, nwg, G, c;
    __host__ __device__ void init(int M, int N, int G_, int c_) { nM = M / BM; nN = N / BM; nwg = nM * nN; G = G_; c = c_; }
    __host__ __device__ bool next(int i, Unit& u) const { return at((long)i * G + c, u); }
    __device__ __forceinline__ const char* aptr(const Gemm& g, const Unit& u, size_t tstep) const { return (const char*)g.A + (size_t)u.pm * tstep; }
    __device__ __forceinline__ const char* bptr(const Gemm& g, const Unit& u, size_t tstep) const { return (const char*)g.Bt + (size_t)u.pn * tstep; }
    __host__ __device__ bool at(long L, Unit& u) const {
        u.kind = 0; if (L >= nwg) return false;
        int wgid = (int)L; { const int q = nwg / NXCD, r = nwg % NXCD, xcd = wgid % NXCD, off = wgid / NXCD; wgid = (xcd < r ? xcd * (q + 1) : r * (q + 1) + (xcd - r) * q) + off; }
        const int nig = WGM * nN, gid = wgid / nig, fm = gid * WGM, gsz = (nM - fm) < WGM ? (nM - fm) : WGM;
        u.pm = fm + ((wgid % nig) % gsz); u.pn = (wgid % nig) / gsz; return true;
    }
    __device__ __forceinline__ void a_ready(const Unit&) const {}
    __device__ __forceinline__ void done(const Unit&) const {}
};

__device__ __forceinline__ unsigned pk2f(float a, float b) { typedef __bf16 b2 __attribute__((ext_vector_type(2))); typedef float f2 __attribute__((ext_vector_type(2)));
    f2 f = {a, b}; b2 r = __builtin_convertvector(f, b2); return __builtin_bit_cast(unsigned, r); }
struct EpiStoreBf16 {
    static constexpr bool PERM = true, AFTER_DRAIN = false;
    bf16_t* O; int ldc; int split_cols; size_t split_stride;
    __device__ __forceinline__ void operator()(const f32x4 (&acc)[2][2][4][2], const Unit& u, int wr, int wc, int fr, int fq) const {
        const int row0 = u.pm * BM + wr * 64 + fr; int colt = u.pn * BM; bf16_t* base = O;
        if (split_cols) { const int t = colt / split_cols; base += (size_t)t * split_stride; colt -= t * split_cols; }
        const int col0 = colt + wc * 32 + 8 * fq;
#pragma unroll
        for (int ai = 0; ai < 2; ++ai)
#pragma unroll
            for (int m = 0; m < 4; ++m) { bf16_t* rowp = base + (size_t)(row0 + ai * HALF + m * 16) * ldc + col0;
#pragma unroll
                for (int bj = 0; bj < 2; ++bj) { const f32x4 v0 = acc[ai][bj][m][0], v1 = acc[ai][bj][m][1];
                    u32x4 w; w.x = pk2f(v0[0], v0[1]); w.y = pk2f(v0[2], v0[3]); w.z = pk2f(v1[0], v1[1]); w.w = pk2f(v1[2], v1[3]);
                    *(u32x4*)(rowp + bj * HALF) = w; } }
    }
};
struct EpiResid {
    static constexpr bool PERM = true, AFTER_DRAIN = false;
    const float* x_in; const float* ctx_in; const bf16_t* xb_in; bf16_t* xb_out; float* out32; const float* gate0; int L;
    __device__ __forceinline__ void operator()(const f32x4 (&acc)[2][2][4][2], const Unit& u, int wr, int wc, int fr, int fq) const {
        const int b = u.pm / 33, pt = u.pm - b * 33; const bool isctx = pt == 0;
        const float* gate = gate0 + (size_t)(isctx ? 4 : b) * 3072;
        const int col0 = u.pn * BM + wc * 32 + 8 * fq;
#pragma unroll
        for (int bj = 0; bj < 2; ++bj) {
            const int c = col0 + bj * HALF;
            const f32x4 g0 = *(const f32x4*)(gate + c), g1 = *(const f32x4*)(gate + c + 4);
#pragma unroll
            for (int ai = 0; ai < 2; ++ai)
#pragma unroll
                for (int m = 0; m < 4; ++m) {
                    const int lrow = wr * 64 + fr + ai * HALF + m * 16, t = pt * 256 + lrow;
                    const size_t grow = (size_t)u.pm * BM + lrow;
                    f32x4 x0, x1;
                    if (L == 0) { const float* src32 = (isctx ? ctx_in + ((size_t)b * 256 + t) * 1024 : x_in + ((size_t)b * 8192 + (t - 256)) * 1024) + c;
                        x0 = *(const f32x4*)(src32); x1 = *(const f32x4*)(src32 + 4); }
                    else { const u32x4 w = *(const u32x4*)(xb_in + grow * 1024 + c);
                        x0 = (f32x4){__uint_as_float(w.x << 16), __uint_as_float(w.x & 0xffff0000u), __uint_as_float(w.y << 16), __uint_as_float(w.y & 0xffff0000u)};
                        x1 = (f32x4){__uint_as_float(w.z << 16), __uint_as_float(w.z & 0xffff0000u), __uint_as_float(w.w << 16), __uint_as_float(w.w & 0xffff0000u)}; }
                    const f32x4 y0 = x0 + g0 * acc[ai][bj][m][0], y1 = x1 + g1 * acc[ai][bj][m][1];
                    if (L == 3) { float* dst32 = out32 + ((size_t)b * 8192 + (t - 256)) * 1024 + c; *(f32x4*)(dst32) = y0; *(f32x4*)(dst32 + 4) = y1; }
                    else { u32x4 w; w.x = pk2f(y0[0], y0[1]); w.y = pk2f(y0[2], y0[3]); w.z = pk2f(y1[0], y1[1]); w.w = pk2f(y1[2], y1[3]); *(u32x4*)(xb_out + grow * 1024 + c) = w; }
                }
        }
    }
};
struct LatentOrder {
    int G, c;
    __device__ bool next(int i, Unit& u) const { const int Lx = i * G + c; if (Lx >= 512) return false; const int lm = Lx >> 2; u.kind = 0; u.pn = Lx & 3; u.pm = (lm >> 5) * 33 + 1 + (lm & 31); return true; }
    __device__ __forceinline__ const char* aptr(const Gemm& g, const Unit& u, size_t tstep) const { return (const char*)g.A + (size_t)u.pm * tstep; }
    __device__ __forceinline__ const char* bptr(const Gemm& g, const Unit& u, size_t tstep) const { return (const char*)g.Bt + (size_t)u.pn * tstep; }
    __device__ __forceinline__ void a_ready(const Unit&) const {}
    __device__ __forceinline__ void done(const Unit&) const {}
};


struct OddOrder {
    StaticOrder s0, s1; const bf16_t* h; const bf16_t* W; int G, c;
    __device__ void init(const bf16_t* h_, const bf16_t* W_, int G_, int c_) { h = h_; W = W_; G = G_; c = c_; s0.init(33792, 3072, G_, c_); s1.init(1024, 33792, G_, c_); }
    __device__ bool next(int i, Unit& u) const { const long L = (long)i * G + c; if (L < s0.nwg) return s0.at(L, u); if (!s1.at(L - s0.nwg, u)) return false; u.kind = 1; return true; }
    __device__ __forceinline__ const char* aptr(const Gemm&, const Unit& u, size_t tstep) const { return (const char*)(u.kind ? W + (size_t)3072 * 1024 : h) + (size_t)u.pm * tstep; }
    __device__ __forceinline__ const char* bptr(const Gemm&, const Unit& u, size_t tstep) const { return (const char*)(u.kind ? h : W) + (size_t)u.pn * tstep; }
    __device__ __forceinline__ void a_ready(const Unit&) const {}
    __device__ __forceinline__ void done(const Unit&) const {}
};
struct EpiOdd {
    static constexpr bool PERM = true, AFTER_DRAIN = false;
    EpiStoreBf16 e0, e1;
    __device__ __forceinline__ void operator()(const f32x4 (&acc)[2][2][4][2], const Unit& u, int wr, int wc, int fr, int fq) const {
        if (u.kind) e1(acc, u, wr, wc, fr, fq); else e0(acc, u, wr, wc, fr, fq);
    }
};
template <class Epi, class Sched, bool STAMP = false>
__device__ __forceinline__ void gemm_phase(PG8_LAS unsigned char* lds, const Gemm g, const Sched& S, const Epi& E, unsigned long long* stamps) {
    int tid = threadIdx.x; asm volatile("" : "+v"(tid));
    const int wid = __builtin_amdgcn_readfirstlane(tid >> 6), lane = tid & 63, wr = wid >> 2, wc = wid & 3, fr = lane & 15, fq = lane >> 4;
    const int K = g.K, nt = K / BK;
    int ts_lo = 0, ts_hi = 0, nts = 0; const unsigned long long rt_entry = STAMP ? 0ull : 0ull;
#define PG8_STAMP() do { if (STAMP && wid == 0 && nts < 64) { const unsigned long long _c = 0ull; \
        ts_lo = (lane == nts) ? (int)(unsigned)_c : ts_lo; ts_hi = (lane == nts) ? (int)(unsigned)(_c >> 32) : ts_hi; ++nts; } } while (0)
    PG8_STAMP();
    unsigned voffA[2], voffB[2];
#pragma unroll
    for (int i = 0; i < 2; ++i) { int R, C; stage_rc(tid * 16 + i * 8192, R, C); const int Rb = Epi::PERM ? ((R & ~31) + perm32(R & 31)) : R;
        voffA[i] = (unsigned)(R * K + C) * 2u; voffB[i] = (unsigned)(Rb * K + C) * 2u; }
    const size_t kstep = (size_t)(BK * 2);
    const size_t hstep = (size_t)HALF * K * 2;
    const size_t tstep = 2 * hstep;
    const unsigned ldsw = (unsigned)wid * 1024u;
    const int aoff = lds_byte(wr * 64 + fr, fq * 8), boff = lds_byte(wc * 32 + fr, fq * 8);
#define PG8_SA(b, h) (((b) * 2 + (h)) * HTB)
#define PG8_SB(b, h) ((4 + (b) * 2 + (h)) * HTB)
#define PG8_STAGE(bufoff, gbase, voff) do { _Pragma("unroll") for (int _i = 0; _i < 2; ++_i) \
        __builtin_amdgcn_global_load_lds((const unsigned*)((const char*)(gbase) + (voff)[_i]), (PG8_LAS unsigned*)(lds + (bufoff) + ldsw + _i * 8192), 16, 0, 0); } while (0)
#define PG8_LDA(dst, b, h) do { _Pragma("unroll") for (int m = 0; m < 4; ++m) _Pragma("unroll") for (int k = 0; k < 2; ++k) dst[m][k] = *(const PG8_LAS bf16x8*)(lds + PG8_SA(b, h) + aoff + m * 2048 + k * 1024); } while (0)
#define PG8_LDB(dst, b, h) do { _Pragma("unroll") for (int n = 0; n < 2; ++n) _Pragma("unroll") for (int k = 0; k < 2; ++k) dst[n][k] = *(const PG8_LAS bf16x8*)(lds + PG8_SB(b, h) + boff + n * 2048 + k * 1024); } while (0)
#define PG8_MMA(ai, bj, At, Bt) do { __builtin_amdgcn_s_setprio(1); _Pragma("unroll") for (int m = 0; m < 4; ++m) _Pragma("unroll") for (int n = 0; n < 2; ++n) _Pragma("unroll") for (int k = 0; k < 2; ++k) \
        acc[ai][bj][m][n] = __builtin_amdgcn_mfma_f32_16x16x32_bf16(Bt[n][k], At[m][k], acc[ai][bj][m][n], 0, 0, 0); __builtin_amdgcn_s_setprio(0); } while (0)
#define PG8_WAIT_V(n) asm volatile("s_waitcnt vmcnt(" #n ")" ::: "memory")
#define PG8_WAIT_L(n) asm volatile("s_waitcnt lgkmcnt(" #n ")" ::: "memory")
#define PG8_BAR __builtin_amdgcn_s_barrier()
#define PG8_SCHED __builtin_amdgcn_sched_barrier(0)
    Unit cur, nxt; int ui = 0;
    if (!S.next(0, cur)) return;
    f32x4 acc[2][2][4][2];
#pragma unroll
    for (int a = 0; a < 2; ++a)
#pragma unroll
        for (int b = 0; b < 2; ++b)
#pragma unroll
            for (int m = 0; m < 4; ++m)
#pragma unroll
                for (int n = 0; n < 2; ++n) acc[a][b][m][n] = (f32x4){0.f, 0.f, 0.f, 0.f};
    bf16x8 At[4][2], B0[2][2], B1[2][2];
    const char* cA = S.aptr(g, cur, tstep); const char* cB = S.bptr(g, cur, tstep);
    S.a_ready(cur);
    PG8_STAGE(PG8_SB(0, 0), cB, voffB); PG8_STAGE(PG8_SA(0, 0), cA, voffA); PG8_STAGE(PG8_SB(0, 1), cB + hstep, voffB); PG8_STAGE(PG8_SA(0, 1), cA + hstep, voffA);
    if (wr == 1) PG8_BAR;
    PG8_WAIT_V(4); PG8_BAR;
    PG8_STAGE(PG8_SB(1, 0), cB + kstep, voffB); PG8_STAGE(PG8_SA(1, 0), cA + kstep, voffA); PG8_STAGE(PG8_SB(1, 1), cB + hstep + kstep, voffB);
    PG8_WAIT_V(6); PG8_BAR;
    PG8_STAMP();
    for (;;) {
        const bool has_next = S.next(ui + 1, nxt);
        const char* nA = has_next ? S.aptr(g, nxt, tstep) : cA; const char* nB = has_next ? S.bptr(g, nxt, tstep) : cB;
        for (int t = 0; t < nt; t += 2) {
            const bool last = (t == nt - 2);
            const char* a1 = cA + (size_t)(t + 1) * kstep;
            const char* a2 = last ? nA : cA + (size_t)(t + 2) * kstep; const char* b2 = last ? nB : cB + (size_t)(t + 2) * kstep;
            const char* a3 = a2 + kstep; const char* b3 = b2 + kstep;
            if (last && has_next) S.a_ready(nxt);
            PG8_LDB(B0, 0, 0); PG8_SCHED; PG8_LDA(At, 0, 0); PG8_STAGE(PG8_SA(1, 1), a1 + hstep, voffA);
            PG8_WAIT_L(8); PG8_BAR; PG8_WAIT_L(0); PG8_MMA(0, 0, At, B0); PG8_BAR; PG8_SCHED;
            PG8_LDB(B1, 0, 1); PG8_STAGE(PG8_SB(0, 0), b2, voffB);
            PG8_BAR; PG8_WAIT_L(0); PG8_MMA(0, 1, At, B1); PG8_BAR;
            PG8_LDA(At, 0, 1); PG8_STAGE(PG8_SA(0, 0), a2, voffA);
            PG8_BAR; PG8_WAIT_L(0); PG8_MMA(1, 0, At, B0); PG8_BAR; PG8_SCHED;
            PG8_STAGE(PG8_SB(0, 1), b2 + hstep, voffB);
            PG8_WAIT_V(6); PG8_BAR; PG8_MMA(1, 1, At, B1); PG8_BAR;
            PG8_LDB(B0, 1, 0); PG8_SCHED; PG8_LDA(At, 1, 0); PG8_STAGE(PG8_SA(0, 1), a2 + hstep, voffA);
            PG8_WAIT_L(8); PG8_BAR; PG8_WAIT_L(0); PG8_MMA(0, 0, At, B0); PG8_BAR; PG8_SCHED;
            PG8_LDB(B1, 1, 1); PG8_STAGE(PG8_SB(1, 0), b3, voffB);
            PG8_BAR; PG8_WAIT_L(0); PG8_MMA(0, 1, At, B1); PG8_BAR;
            PG8_LDA(At, 1, 1); PG8_STAGE(PG8_SA(1, 0), a3, voffA);
            PG8_BAR; PG8_WAIT_L(0); PG8_MMA(1, 0, At, B0); PG8_BAR; PG8_SCHED;
            PG8_STAGE(PG8_SB(1, 1), b3 + hstep, voffB);
            PG8_WAIT_V(6); PG8_BAR; PG8_MMA(1, 1, At, B1); PG8_BAR;
        }
        PG8_STAMP();
        if constexpr (!Epi::AFTER_DRAIN) { E(acc, cur, wr, wc, fr, fq); S.done(cur); }
        PG8_STAMP();
        if (!has_next) break;
#pragma unroll
        for (int a = 0; a < 2; ++a)
#pragma unroll
            for (int b = 0; b < 2; ++b)
#pragma unroll
                for (int m = 0; m < 4; ++m)
#pragma unroll
                    for (int n = 0; n < 2; ++n) acc[a][b][m][n] = (f32x4){0.f, 0.f, 0.f, 0.f};
        cur = nxt; cA = nA; cB = nB; ++ui;
    }
    PG8_WAIT_V(0);
    if (wr == 0) PG8_BAR;
    PG8_BAR;
    if constexpr (Epi::AFTER_DRAIN) { E.fused(acc, cur, wr, wc, fr, fq, lds, wid, lane); S.done(cur); }
    PG8_STAMP();
    if (STAMP && wid == 0) { stamps[lane] = lane < nts ? (((unsigned long long)(unsigned)ts_hi << 32) | (unsigned)ts_lo) : 0ull;
        if (lane == 62) stamps[62] = rt_entry; if (lane == 63) stamps[63] = 0ull; }
#undef PG8_STAMP
#undef PG8_SA
#undef PG8_SB
#undef PG8_STAGE
#undef PG8_LDA
#undef PG8_LDB
#undef PG8_MMA
#undef PG8_WAIT_V
#undef PG8_WAIT_L
#undef PG8_BAR
#undef PG8_SCHED
}
}


DI void phase_win_even8(const Params& p, int li, char* lds) {
  pg8::Gemm g{(const u16*)(p.ws + OFF_H), (const u16*)(p.ws + OFF_WINE + li * SZ_WINE), M, 2048, 1024};
  pg8::StaticOrder S; S.init(g.M, g.N, (int)gridDim.x, pbid());
  pg8::EpiStoreBf16 E{(u16*)(p.ws + OFF_ZE), 2048, 0, 0};
  pg8::gemm_phase<pg8::EpiStoreBf16, pg8::StaticOrder, false>((PG8_LAS unsigned char*)lds, g, S, E, nullptr);
}
DI void phase_win_odd8(const Params& p, int li, char* lds) {
  const u16* W = (const u16*)(p.ws + OFF_WINO + li * SZ_WINO);
  const u16* h = (const u16*)(p.ws + OFF_H);
  pg8::Gemm g{h, W, M, 3072, 1024};
  pg8::OddOrder S; S.init(h, W, (int)gridDim.x, pbid());
  pg8::EpiOdd E{pg8::EpiStoreBf16{(u16*)(p.ws + OFF_ZO), 3072, 0, 0}, pg8::EpiStoreBf16{(u16*)(p.ws + OFF_VTO), TB, TB, (size_t)1024 * TB}};
  pg8::gemm_phase<pg8::EpiOdd, pg8::OddOrder, false>((PG8_LAS unsigned char*)lds, g, S, E, nullptr);
}
DI void phase_out8(const Params& p, int L, char* lds) {
  const int li = L >> 1;
  pg8::Gemm g{(const u16*)(p.ws + OFF_H), (const u16*)(p.ws + ((L & 1) ? OFF_WOUTO : OFF_WOUTE) + li * SZ_WOUT), M, 1024, 1024};
  pg8::EpiResid E{p.x, p.ctx, (const u16*)(p.ws + OFF_XB), (u16*)(p.ws + OFF_XB), p.out, (const float*)(p.ws + OFF_MOD) + (size_t)L * 5 * 3072 + 2048, L};
  if (L == 3) {
    pg8::LatentOrder S{(int)gridDim.x, pbid()};
    pg8::gemm_phase<pg8::EpiResid, pg8::LatentOrder, false>((PG8_LAS unsigned char*)lds, g, S, E, nullptr);
  } else {
    pg8::StaticOrder S; S.init(g.M, g.N, (int)gridDim.x, pbid());
    pg8::gemm_phase<pg8::EpiResid, pg8::StaticOrder, false>((PG8_LAS unsigned char*)lds, g, S, E, nullptr);
  }
}

#define XB_TMO      128
#define XB_XCNT(j)  (256  + 64 * (j))
#define XB_XSUB(j)  (1280 + 64 * (j))
#define XB_XGEN(j)  (2304 + 64 * (j))
#define XB_TOP      3328
#define XB_TOPGEN   3392
#define XCD_BAR_WORDS 3456
#define XB_SPIN_CAP (1u << 22)
#define LAS __attribute__((address_space(3)))
DI unsigned xb_ld(unsigned* p)              { return __hip_atomic_load(p, __ATOMIC_RELAXED, __HIP_MEMORY_SCOPE_AGENT); }
DI unsigned xb_add(unsigned* p, unsigned v) { return __hip_atomic_fetch_add(p, v, __ATOMIC_RELAXED, __HIP_MEMORY_SCOPE_AGENT); }
DI unsigned xb_xcc_id() { return (unsigned)__builtin_amdgcn_s_getreg((3 << 11) | 20) & 0xFu; }
#define XB_SPIN(cond, bar) do { unsigned _sp = 0; while (cond) { __builtin_amdgcn_s_sleep(1); \
    if ((++_sp & 255u) == 0u) { if (xb_ld(&(bar)[XB_TMO])) break; if (_sp > XB_SPIN_CAP) { atomicAdd(&(bar)[XB_TMO], 1u); break; } } } } while (0)
struct XcdBarrier { unsigned* bar; unsigned x; volatile LAS unsigned* st; };
DI XcdBarrier xcd_barrier_post(unsigned* bar, volatile LAS unsigned* st) {
  XcdBarrier b; b.bar = bar; b.x = xb_xcc_id(); b.st = st;
  if (threadIdx.x == 0) (void)xb_add(&bar[XB_XCNT(b.x)], 1u);
  return b;
}
DI void xcd_barrier_complete(unsigned* bar, unsigned x, unsigned& nloc, unsigned& nx) {
  const unsigned G = gridDim.x * gridDim.y * gridDim.z;
  unsigned sum, cnt, mine, sp = 0u;
  for (;;) {
    sum = 0u; cnt = 0u; mine = 0u;
#pragma unroll
    for (unsigned j = 0; j < 16; ++j) { const unsigned c = xb_ld(&bar[XB_XCNT(j)]); sum += c; cnt += (c > 0u) ? 1u : 0u; mine = (j == x) ? c : mine; }
    if (sum == G) break;
    __builtin_amdgcn_s_sleep(1);
    if ((++sp & 255u) == 0u) { if (xb_ld(&bar[XB_TMO])) break; if (sp > XB_SPIN_CAP) { atomicAdd(&bar[XB_TMO], 1u); break; } }
  }
  nloc = mine > 0u ? mine : 1u; nx = cnt > 0u ? cnt : 1u;
}
DI void xcd_barrier(const XcdBarrier& b) {
  asm volatile("s_waitcnt vmcnt(0)" ::: "memory");
  __syncthreads();
  if (threadIdx.x == 0) {
    unsigned* bar = b.bar;
    __builtin_amdgcn_s_waitcnt(0);
    unsigned nloc = b.st[0], nx = b.st[1];
    if (nloc == 0u) { xcd_barrier_complete(bar, b.x, nloc, nx); b.st[0] = nloc; b.st[1] = nx; }
    const unsigned old = xb_add(&bar[XB_XSUB(b.x)], 1u);
    const unsigned gen = old / nloc;
    if (old + 1u == (gen + 1u) * nloc) {
      __builtin_amdgcn_fence(__ATOMIC_RELEASE, "agent");
      asm volatile("s_waitcnt vmcnt(0)" ::: "memory");
      const unsigned og = xb_add(&bar[XB_TOP], 1u);
      const unsigned tg = og / nx;
      if (og + 1u == (tg + 1u) * nx) xb_add(&bar[XB_TOPGEN], 1u);
      else XB_SPIN(xb_ld(&bar[XB_TOPGEN]) == tg, bar);
      __builtin_amdgcn_fence(__ATOMIC_ACQUIRE, "agent");
      xb_add(&bar[XB_XGEN(b.x)], 1u);
      asm volatile("s_waitcnt vmcnt(0)" ::: "memory");
    } else {
      XB_SPIN(xb_ld(&bar[XB_XGEN(b.x)]) == gen, bar);
      __builtin_amdgcn_fence(__ATOMIC_ACQUIRE, "agent");
      asm volatile("s_waitcnt vmcnt(0)" ::: "memory");
    }
  }
  __syncthreads();
}

DI void phase_lru_carry(const Params& p) {
  float* aggA = (float*)(p.ws + OFF_AGGA);
  float* aggH = (float*)(p.ws + OFF_AGGH);
  const int g = lbid() * 256 + ltid();
  if (g >= NB * 2 * 512) return;
  const int b = g >> 10, d = (g >> 9) & 1, c = g & 511;
  const size_t ob = (size_t)b * NCH * 1024 + d * 512 + c;
  float hh = 0.f;
  for (int s0 = 0; s0 < NCH; s0 += 12) {
    float a[12], hv[12]; size_t o[12];
#pragma unroll
    for (int u = 0; u < 12; ++u) {
      const int s = s0 + u;
      const int j = d == 0 ? s : (s < 4 ? 3 - s : NCH + 3 - s);
      o[u] = ob + (size_t)j * 1024; a[u] = aggA[o[u]]; hv[u] = aggH[o[u]];
    }
#pragma unroll
    for (int u = 0; u < 12; ++u) { aggH[o[u]] = hh; hh = a[u] * hh + hv[u]; }
  }
}

#ifndef DUP
#define DUP 0
#endif
#define REP(k) for (int rep_ = 0; rep_ < ((DUP) == (k) ? 2 : 1); ++rep_)
constexpr int HALF_LDS = 65536;
constexpr int DYN_LDS = 2 * HALF_LDS + 16;
__global__ void __launch_bounds__(512, 2) mega(Params p) {
  extern __shared__ __attribute__((aligned(16))) char dyn_smem[];
  char* smem = dyn_smem + lhalf() * HALF_LDS;
  uint4* xbw = (uint4*)(dyn_smem + 2 * HALF_LDS);
  cg::grid_group grid = cg::this_grid();
  if (threadIdx.x == 0) *xbw = make_uint4(0u, 0u, 0u, 0u);
  __syncthreads();
  const XcdBarrier xbar = xcd_barrier_post((unsigned*)(p.ws + OFF_BAR), (volatile LAS unsigned*)xbw);
  REP(9) phase_prep(p, smem);
  grid.sync();
  for (int L = 0; L < NLAYERS_RUN; ++L) {
    const int li = L >> 1;
    REP(1) phase_norm(p, L);
    do { xcd_barrier(xbar); if (DUP == 10) xcd_barrier(xbar); } while (0);
    if ((L & 1) == 0) {
      REP(2) phase_win_even8(p, li, dyn_smem);
      do { xcd_barrier(xbar); if (DUP == 10) xcd_barrier(xbar); } while (0);
      REP(3) phase_e2(p, li, smem);
      do { xcd_barrier(xbar); if (DUP == 10) xcd_barrier(xbar); } while (0);
      phase_lru_carry(p);
      do { xcd_barrier(xbar); if (DUP == 10) xcd_barrier(xbar); } while (0);
      REP(4) phase_e3(p, li, smem);
      do { xcd_barrier(xbar); if (DUP == 10) xcd_barrier(xbar); } while (0);
    } else {
      REP(6) phase_win_odd8(p, li, dyn_smem);
      do { xcd_barrier(xbar); if (DUP == 10) xcd_barrier(xbar); } while (0);
      REP(7) phase_na(p, li, L < 3 ? 4096 + 128 : 4096, smem);
      do { xcd_barrier(xbar); if (DUP == 10) xcd_barrier(xbar); } while (0);
    }
    phase_out8(p, L, dyn_smem);
    do { xcd_barrier(xbar); if (DUP == 10) xcd_barrier(xbar); } while (0);
  }
  phase_final_norm(p);
}

extern "C" void kernel_launch(void* const* d_in, const int* in_sizes, int n_in, void* d_out, int out_size, void* d_ws, size_t ws_size,
                              hipStream_t stream) {
  static int grid_blocks = 0;
  if (!grid_blocks) {
    int dev = 0, cus = 0, per_cu = 0;
    (void)hipGetDevice(&dev);
    (void)hipDeviceGetAttribute(&cus, hipDeviceAttributeMultiprocessorCount, dev);
    if (hipFuncSetAttribute((const void*)mega, hipFuncAttributeMaxDynamicSharedMemorySize, DYN_LDS) != hipSuccess) { fprintf(stderr, "kernel_launch: hipFuncSetAttribute(%d B LDS) failed\n", DYN_LDS); return; }
    (void)hipOccupancyMaxActiveBlocksPerMultiprocessor(&per_cu, mega, 512, DYN_LDS);
    (void)hipGetLastError();
    grid_blocks = cus & ~7;
  }
  if (ws_size < WS_NEED) { fprintf(stderr, "kernel_launch: workspace too small: %zu < %zu\n", ws_size, WS_NEED); return; }
  if (hipMemsetAsync((char*)d_ws + OFF_BAR, 0, 16384, stream) != hipSuccess) { fprintf(stderr, "kernel_launch: memset failed\n"); return; }
  Params p{};
  const float** f = (const float**)&p;
  for (int i = 0; i < 24; ++i) f[i] = (const float*)d_in[i];
  p.out = (float*)d_out;
  p.ws = (char*)d_ws;
  void* args[] = {&p};
  hipError_t e = hipLaunchCooperativeKernel((void*)mega, dim3(grid_blocks), dim3(512), args, DYN_LDS, stream);
  if (e != hipSuccess) fprintf(stderr, "cooperative launch failed: %s (grid %d)\n", hipGetErrorString(e), grid_blocks);
}
```
